# Optimizing an MI355X kernel written in HIP

```python
import math
import jax, jax.numpy as jnp
from jax import lax
import numpy as np

D_MODEL = 1024
BATCH = 8
SEQ = 4096
DEPTH = 1

GRID_W = 64
CTX_LEN = 256
N_HEADS = 8
HEAD_DIM = 64
ATTN_WIDTH = N_HEADS * HEAD_DIM
WIN_H_MAX = 8
WIN_W = 16
Q_COL_BLOCK = 16
BAND_W = 32
ROPE_BASE = 10000.0
SSM_WIDTH = 512
SSM_GROUP = 16
SSM_GROUPS = SSM_WIDTH // SSM_GROUP
SSM_STATE = 64
DT_MIN = 0.001
DT_MAX = 0.1
FFN_HIDDEN = ((8 * D_MODEL // 3 + 255) // 256) * 256
IN_COLS = 3 * ATTN_WIDTH + SSM_WIDTH + 2 * D_MODEL
N_MOD = 6
NORM_EPS = 1e-6
NEG_BIG = -1e30

kernel_name = 'hybrid_natten_s5_dit_block'


def rmsnorm(x, g):
    xf = x.astype(jnp.float32)
    xf = xf * lax.rsqrt(jnp.mean(xf * xf, axis=-1, keepdims=True) + NORM_EPS)
    return xf.astype(x.dtype) * g


def modulate(h, shift, scale):
    return h * (1.0 + scale) + shift


def heads(t):
    return t.reshape(t.shape[0], t.shape[1], N_HEADS, HEAD_DIM)


def axial_rope(x):
    L = x.shape[1]
    t = jnp.arange(L, dtype=jnp.int32)
    n_freq = HEAD_DIM // 4
    inv_freq = ROPE_BASE ** (-jnp.arange(n_freq, dtype=jnp.float32) / n_freq)

    def rotate(xa, pos):
        ang = pos.astype(jnp.float32)[:, None] * inv_freq[None, :]
        cos = jnp.cos(ang)[None, :, None, :].astype(x.dtype)
        sin = jnp.sin(ang)[None, :, None, :].astype(x.dtype)
        x1, x2 = xa[..., :n_freq], xa[..., n_freq:]
        return jnp.concatenate([x1 * cos - x2 * sin, x2 * cos + x1 * sin], axis=-1)

    half = HEAD_DIM // 2
    return jnp.concatenate([rotate(x[..., :half], t // GRID_W), rotate(x[..., half:], t % GRID_W)], axis=-1)


def neighbourhood_attention(q, k, v, k_ctx, v_ctx, rpb):
    B, L, H, d = q.shape
    rows = L // GRID_W
    kh = min(WIN_H_MAX, rows)
    n_cb = GRID_W // Q_COL_BLOCK
    qg = q.reshape(B, rows, n_cb, Q_COL_BLOCK, H, d)
    kg = k.reshape(B, rows, GRID_W, H, d)
    vg = v.reshape(B, rows, GRID_W, H, d)
    qcol = np.arange(GRID_W).reshape(n_cb, Q_COL_BLOCK)
    col_start = np.clip(qcol - WIN_W // 2, 0, GRID_W - WIN_W)
    band_start = np.clip(np.arange(n_cb) * Q_COL_BLOCK - WIN_W // 2, 0, GRID_W - BAND_W)
    band_idx = band_start[:, None] + np.arange(BAND_W)[None, :]
    kcol = band_idx[:, None, :]
    in_win = (kcol >= col_start[..., None]) & (kcol < col_start[..., None] + WIN_W)
    dc_idx = np.clip(kcol - qcol[..., None], -(WIN_W - 1), WIN_W - 1) + WIN_W - 1
    scale = HEAD_DIM ** -0.5
    n_loc = kh * BAND_W

    def one_row(r):
        rs = jnp.clip(r - kh // 2, 0, rows - kh)
        k_band = lax.dynamic_slice_in_dim(kg, rs, kh, axis=1)[:, :, band_idx]
        v_band = lax.dynamic_slice_in_dim(vg, rs, kh, axis=1)[:, :, band_idx]
        q_r = lax.dynamic_index_in_dim(qg, r, axis=1, keepdims=False)
        s_loc = jnp.einsum('bcqhd,bkcnhd->bhcqkn', q_r, k_band).astype(jnp.float32) * scale
        dr_idx = rs + jnp.arange(kh) - r + WIN_H_MAX - 1
        bias = rpb[:, dr_idx][:, :, dc_idx]
        bias = jnp.transpose(bias, (0, 2, 3, 1, 4)).astype(jnp.float32)
        s_loc = jnp.where(in_win[:, :, None, :], s_loc + bias, NEG_BIG)
        s_ctx = jnp.einsum('bcqhd,bmhd->bhcqm', q_r, k_ctx).astype(jnp.float32) * scale
        s = jnp.concatenate([s_loc.reshape(B, H, n_cb, Q_COL_BLOCK, n_loc), s_ctx], axis=-1)
        p = jax.nn.softmax(s, axis=-1).astype(q.dtype)
        p_loc = p[..., :n_loc].reshape(B, H, n_cb, Q_COL_BLOCK, kh, BAND_W)
        p_ctx = p[..., n_loc:]
        o = (jnp.einsum('bhcqkn,bkcnhd->bcqhd', p_loc, v_band)
             + jnp.einsum('bhcqm,bmhd->bcqhd', p_ctx, v_ctx))
        return o.reshape(B, GRID_W, H, d)

    out = lax.map(one_row, jnp.arange(rows, dtype=jnp.int32))
    return jnp.moveaxis(out, 0, 1).reshape(B, L, H * d)


def context_attention(q, k, v):
    s = jnp.einsum('bqhd,bkhd->bhqk', q, k).astype(jnp.float32) * (HEAD_DIM ** -0.5)
    p = jax.nn.softmax(s, axis=-1).astype(q.dtype)
    return jnp.einsum('bhqk,bkhd->bqhd', p, v).reshape(q.shape[0], q.shape[1], ATTN_WIDTH)


def s5_discretise(lam_re, lam_im, log_dt, b_re, b_im):
    dt = jnp.exp(log_dt)[:, None]
    mag = jnp.exp(lam_re * dt)
    ang = lam_im * dt
    lb_re, lb_im = mag * jnp.cos(ang), mag * jnp.sin(ang)
    den = lam_re * lam_re + lam_im * lam_im
    nr, ni = lb_re - 1.0, lb_im
    f_re = (nr * lam_re + ni * lam_im) / den
    f_im = (ni * lam_re - nr * lam_im) / den
    bb_re = f_re[..., None] * b_re - f_im[..., None] * b_im
    bb_im = f_re[..., None] * b_im + f_im[..., None] * b_re
    return lb_re, lb_im, bb_re, bb_im


def _linear_combine(e1, e2):
    a1r, a1i, b1r, b1i = e1
    a2r, a2i, b2r, b2i = e2
    return (a2r * a1r - a2i * a1i, a2r * a1i + a2i * a1r,
            a2r * b1r - a2i * b1i + b2r, a2r * b1i + a2i * b1r + b2i)


def diag_scan(lb_re, lb_im, bu_re, bu_im):
    L = bu_re.shape[1]
    a_re = jnp.broadcast_to(lb_re, (1, L) + lb_re.shape)
    a_im = jnp.broadcast_to(lb_im, (1, L) + lb_im.shape)
    return lax.associative_scan(_linear_combine, (a_re, a_im, bu_re, bu_im), axis=1)


def s5_direction(u_ctx, u_lat, lam_re, lam_im, log_dt, b_re, b_im, c_re, c_im, reverse, need_ctx):
    lb_re, lb_im, bb_re, bb_im = s5_discretise(lam_re, lam_im, log_dt, b_re, b_im)

    def drive(u):
        u = jnp.flip(u, axis=1) if reverse else u
        return (jnp.einsum('blgh,gph->blgp', u, bb_re), jnp.einsum('blgh,gph->blgp', u, bb_im))

    def readout(hr, hi):
        y = jnp.einsum('blgp,ghp->blgh', hr, c_re) - jnp.einsum('blgp,ghp->blgh', hi, c_im)
        return jnp.flip(y, axis=1) if reverse else y

    ur, ui = drive(u_ctx)
    _, _, hc_re, hc_im = diag_scan(lb_re, lb_im, ur, ui)
    h0_re, h0_im = hc_re[:, -1:], hc_im[:, -1:]
    ur, ui = drive(u_lat)
    ac_re, ac_im, hl_re, hl_im = diag_scan(lb_re, lb_im, ur, ui)
    hl_re = hl_re + ac_re * h0_re - ac_im * h0_im
    hl_im = hl_im + ac_re * h0_im + ac_im * h0_re
    y_ctx = readout(hc_re, hc_im) if need_ctx else None
    return y_ctx, readout(hl_re, hl_im)


def s5_branch(u_ctx, u_lat, lam_re, lam_im, log_dt, b_re, b_im, c_re, c_im, d_skip, w_glu, need_ctx):
    B, Lc, _ = u_ctx.shape
    L = u_lat.shape[1]
    ucg = u_ctx.reshape(B, Lc, SSM_GROUPS, SSM_GROUP)
    ulg = u_lat.reshape(B, L, SSM_GROUPS, SSM_GROUP)
    fwd = s5_direction(ucg, ulg, lam_re[0], lam_im[0], log_dt[0], b_re[0], b_im[0], c_re[0], c_im[0], False, need_ctx)
    bwd = s5_direction(ucg, ulg, lam_re[1], lam_im[1], log_dt[1], b_re[1], b_im[1], c_re[1], c_im[1], True, need_ctx)

    def finish(y_f, y_b, u):
        y = jax.nn.gelu((y_f + y_b).reshape(u.shape) + d_skip * u)
        val, gate = jnp.split(y @ w_glu, 2, axis=-1)
        return val * jax.nn.sigmoid(gate)

    y_lat = finish(fwd[1], bwd[1], u_lat)
    y_ctx = finish(fwd[0], bwd[0], u_ctx) if need_ctx else None
    return y_ctx, y_lat


def token_mixer(n_ctx, n_lat, w_in, rpb, lam_re, lam_im, log_dt, b_re, b_im, c_re, c_im, d_skip, w_glu,
                w_branch_attn, w_branch_ssm, w_out, need_ctx):
    cuts = [ATTN_WIDTH, 2 * ATTN_WIDTH, 3 * ATTN_WIDTH, 3 * ATTN_WIDTH + SSM_WIDTH,
            3 * ATTN_WIDTH + SSM_WIDTH + D_MODEL]
    qc, kc, vc, uc, gac, gsc = jnp.split(n_ctx @ w_in, cuts, axis=-1)
    ql, kl, vl, ul, gal, gsl = jnp.split(n_lat @ w_in, cuts, axis=-1)
    kc_h, vc_h = heads(kc), heads(vc)
    a_lat = neighbourhood_attention(axial_rope(heads(ql)), axial_rope(heads(kl)), heads(vl), kc_h, vc_h, rpb)
    s_ctx, s_lat = s5_branch(uc, ul, lam_re, lam_im, log_dt, b_re, b_im, c_re, c_im, d_skip, w_glu, need_ctx)

    def merge(a, s, ga, gs):
        return (jax.nn.sigmoid(ga) * (a @ w_branch_attn) + jax.nn.sigmoid(gs) * (s @ w_branch_ssm)) @ w_out

    out_lat = merge(a_lat, s_lat, gal, gsl)
    out_ctx = merge(context_attention(heads(qc), kc_h, vc_h), s_ctx, gac, gsc) if need_ctx else None
    return out_ctx, out_lat


def swiglu(h, w_ffn_in, w_ffn_out):
    a, b = jnp.split(h @ w_ffn_in, 2, axis=-1)
    return (jax.nn.silu(a) * b) @ w_ffn_out


def setup_inputs(seed: int = 0) -> dict:
    key = jax.random.key(seed)
    ks = jax.random.split(key, 26)
    f32 = jnp.float32

    def nrm(k, shape, s):
        return s * jax.random.normal(k, shape, f32)

    G, P, HG = SSM_GROUPS, SSM_STATE, SSM_GROUP
    n_idx = jnp.arange(P, dtype=f32)
    return {
        'x': nrm(ks[0], (BATCH, SEQ, D_MODEL), 1.0),
        'c': nrm(ks[1], (BATCH, D_MODEL), 1.0),
        'ctx': nrm(ks[2], (BATCH, CTX_LEN, D_MODEL), 1.0),
        'c_ctx': nrm(ks[3], (D_MODEL,), 1.0),
        'w_mod': nrm(ks[4], (DEPTH, D_MODEL, N_MOD * D_MODEL), D_MODEL ** -0.5),
        'b_mod': nrm(ks[5], (DEPTH, N_MOD * D_MODEL), 0.01),
        'attn_norm_g': 1.0 + nrm(ks[6], (DEPTH, D_MODEL), 0.01),
        'ffn_norm_g': 1.0 + nrm(ks[7], (DEPTH, D_MODEL), 0.01),
        'w_in': nrm(ks[8], (DEPTH, D_MODEL, IN_COLS), D_MODEL ** -0.5),
        'rel_pos_bias': nrm(ks[9], (DEPTH, N_HEADS, 2 * WIN_H_MAX - 1, 2 * WIN_W - 1), 0.1),
        'ssm_lambda_re': -0.5 + nrm(ks[10], (DEPTH, 2, G, P), 0.01),
        'ssm_lambda_im': math.pi * n_idx + nrm(ks[11], (DEPTH, 2, G, P), 0.01),
        'ssm_log_dt': jax.random.uniform(ks[12], (DEPTH, 2, G), f32, math.log(DT_MIN), math.log(DT_MAX)),
        'ssm_b_re': nrm(ks[13], (DEPTH, 2, G, P, HG), (2 * HG) ** -0.5),
        'ssm_b_im': nrm(ks[14], (DEPTH, 2, G, P, HG), (2 * HG) ** -0.5),
        'ssm_c_re': nrm(ks[15], (DEPTH, 2, G, HG, P), P ** -0.5),
        'ssm_c_im': nrm(ks[16], (DEPTH, 2, G, HG, P), P ** -0.5),
        'ssm_d': nrm(ks[17], (DEPTH, SSM_WIDTH), 1.0),
        'w_glu': nrm(ks[18], (DEPTH, SSM_WIDTH, 2 * SSM_WIDTH), SSM_WIDTH ** -0.5),
        'w_branch_attn': nrm(ks[19], (DEPTH, ATTN_WIDTH, D_MODEL), ATTN_WIDTH ** -0.5),
        'w_branch_ssm': nrm(ks[20], (DEPTH, SSM_WIDTH, D_MODEL), SSM_WIDTH ** -0.5),
        'w_out': nrm(ks[21], (DEPTH, D_MODEL, D_MODEL), D_MODEL ** -0.5),
        'w_ffn_in': nrm(ks[22], (DEPTH, D_MODEL, 2 * FFN_HIDDEN), D_MODEL ** -0.5),
        'w_ffn_out': nrm(ks[23], (DEPTH, FFN_HIDDEN, D_MODEL), FFN_HIDDEN ** -0.5),
        'final_norm_g': 1.0 + nrm(ks[24], (D_MODEL,), 0.01),
    }


def reference(x, c, ctx, c_ctx, w_mod, b_mod, attn_norm_g, ffn_norm_g, w_in, rel_pos_bias,
              ssm_lambda_re, ssm_lambda_im, ssm_log_dt, ssm_b_re, ssm_b_im, ssm_c_re, ssm_c_im, ssm_d,
              w_glu, w_branch_attn, w_branch_ssm, w_out, w_ffn_in, w_ffn_out, final_norm_g):
    h = x
    hc = ctx
    for layer in range(DEPTH):
        need_ctx = layer < DEPTH - 1
        sh1, sc1, g1, sh2, sc2, g2 = jnp.split((jax.nn.silu(c) @ w_mod[layer] + b_mod[layer])[:, None, :], N_MOD, axis=-1)
        csh1, csc1, cg1, csh2, csc2, cg2 = jnp.split(jax.nn.silu(c_ctx) @ w_mod[layer] + b_mod[layer], N_MOD, axis=-1)
        n_lat = modulate(rmsnorm(h, attn_norm_g[layer]), sh1, sc1)
        n_ctx = modulate(rmsnorm(hc, attn_norm_g[layer]), csh1, csc1)
        mix_ctx, mix_lat = token_mixer(n_ctx, n_lat, w_in[layer], rel_pos_bias[layer],
                                       ssm_lambda_re[layer], ssm_lambda_im[layer], ssm_log_dt[layer],
                                       ssm_b_re[layer], ssm_b_im[layer], ssm_c_re[layer], ssm_c_im[layer],
                                       ssm_d[layer], w_glu[layer], w_branch_attn[layer], w_branch_ssm[layer],
                                       w_out[layer], need_ctx)
        h = h + g1 * mix_lat
        h = h + g2 * swiglu(modulate(rmsnorm(h, ffn_norm_g[layer]), sh2, sc2), w_ffn_in[layer], w_ffn_out[layer])
        if need_ctx:
            hc = hc + cg1 * mix_ctx
            hc = hc + cg2 * swiglu(modulate(rmsnorm(hc, ffn_norm_g[layer]), csh2, csc2), w_ffn_in[layer], w_ffn_out[layer])
    return rmsnorm(h, final_norm_g)
```

```cpp
#include <hip/hip_runtime.h>
#include <hip/hip_cooperative_groups.h>
#include <cstdio>
namespace cg = cooperative_groups;

#ifndef ONE_LAUNCH
#define ONE_LAUNCH 1
#endif

#define LAS __attribute__((address_space(3)))
typedef unsigned short bf16_t;
typedef short bf16x8 __attribute__((ext_vector_type(8)));
typedef float f32x4 __attribute__((ext_vector_type(4)));
typedef float f32x2 __attribute__((ext_vector_type(2)));
typedef unsigned u32x4 __attribute__((ext_vector_type(4)));
typedef unsigned u32x2 __attribute__((ext_vector_type(2)));

constexpr int NB = 8, SEQL = 4096, DM = 1024, LCTX = 256, NH = 8, HD = 64, AW = 512, SW = 512, NG = 32, NP = 64, HG = 16, FH = 2816, INC = 4096;
constexpr int MLAT = NB * SEQL;
constexpr int MCTX = NB * LCTX;
constexpr int MALL = MLAT + MCTX;
constexpr int XH_ROWS = 2304;
constexpr float NORM_EPS = 1e-6f;
constexpr float LOG2E = 1.4426950408889634f;

constexpr size_t MiB = (size_t)1 << 20;
constexpr size_t WS_MOD = 0;
constexpr size_t WS_ROPE = 256 * 1024;
constexpr size_t WS_LBT = WS_ROPE + 16 * 1024;
constexpr size_t WS_SS1 = 512 * 1024;
constexpr size_t WS_SS2 = 640 * 1024;
constexpr size_t WS_BIAS2 = 768 * 1024;
constexpr size_t WS_BAR = 1024 * 1024;
constexpr size_t WS_WIN = 2 * MiB;
constexpr size_t WS_WGLU = 10 * MiB;
constexpr size_t WS_WBA = 11 * MiB;
constexpr size_t WS_WBS = 12 * MiB;
constexpr size_t WS_WOUT = 13 * MiB;
constexpr size_t WS_WFI = 15 * MiB;
constexpr size_t WS_WFO = 26 * MiB;
constexpr size_t WS_S5W1 = 32 * MiB;
constexpr size_t WS_S5M2 = 36 * MiB;
constexpr size_t WS_A = 44 * MiB;
constexpr size_t WS_B = 112 * MiB;
constexpr size_t WS_C = 144 * MiB;
constexpr size_t WS_D = 212 * MiB;
constexpr size_t WS_F = 284 * MiB;
constexpr size_t WS_E = 412 * MiB;
constexpr size_t WS_SSP1 = 484 * MiB;
constexpr size_t WS_SSP2 = 486 * MiB;
constexpr size_t WS_END = 488 * MiB;
constexpr size_t WS_HID = WS_A;

typedef __bf16 bf16x2_t __attribute__((ext_vector_type(2)));
__device__ __forceinline__ unsigned cvt_pk_bf16(float lo, float hi) { f32x2 f = {lo, hi}; bf16x2_t v = __builtin_convertvector(f, bf16x2_t); return __builtin_bit_cast(unsigned, v); }
__device__ __forceinline__ bf16_t f2bf(float v) { return (bf16_t)(cvt_pk_bf16(v, 0.f) & 0xffffu); }
__device__ __forceinline__ float bf2f(unsigned short b) { return __uint_as_float(((unsigned)b) << 16); }
__device__ __forceinline__ float bflo(unsigned w) { return __uint_as_float(w << 16); }
__device__ __forceinline__ float bfhi(unsigned w) { return __uint_as_float(w & 0xffff0000u); }
__device__ __forceinline__ float xmax32(float x) { auto r = __builtin_amdgcn_permlane32_swap(__float_as_uint(x), __float_as_uint(x), false, false); return fmaxf(__uint_as_float(r[0]), __uint_as_float(r[1])); }
__device__ __forceinline__ float xmax16(float x) { auto r = __builtin_amdgcn_permlane16_swap(__float_as_uint(x), __float_as_uint(x), false, false); return fmaxf(__uint_as_float(r[0]), __uint_as_float(r[1])); }
__device__ __forceinline__ float xsum32(float x) { auto r = __builtin_amdgcn_permlane32_swap(__float_as_uint(x), __float_as_uint(x), false, false); return __uint_as_float(r[0]) + __uint_as_float(r[1]); }
__device__ __forceinline__ float xsum16(float x) { auto r = __builtin_amdgcn_permlane16_swap(__float_as_uint(x), __float_as_uint(x), false, false); return __uint_as_float(r[0]) + __uint_as_float(r[1]); }
__device__ __forceinline__ float fast_sigmoid(float x) { return __builtin_amdgcn_rcpf(1.0f + __builtin_amdgcn_exp2f(-x * LOG2E)); }

namespace pg8 {
constexpr int BM = 256, BK = 64, HALF = 128, HTB = HALF * BK * 2, STAGE_BYTES = 8 * HTB, NXCD = 8, WGM = 8;
__host__ __device__ __forceinline__ int lds_byte(int r, int c) { const int st = (r >> 4) * 2 + (c >> 5), rr = r & 15, cc = c & 31, ob = rr * 64 + cc * 2; return st * 1024 + (ob ^ (((ob >> 9) & 1) << 5)); }
__host__ __device__ __forceinline__ void stage_rc(int b, int& R, int& C) { const int st = b / 1024, sb = b % 1024, swz = sb ^ (((sb >> 9) & 1) << 5); R = (st >> 1) * 16 + swz / 64; C = (st & 1) * 32 + (swz % 64) / 2; }
__host__ __device__ __forceinline__ int perm32(int rho) { const int n = rho >> 4, i = rho & 15; return 8 * (i >> 2) + 4 * n + (i & 3); }

struct Unit { int pm, pn; };
struct Gemm { const bf16_t* A; const bf16_t* Bt; int lda, ldb, K; };

struct StaticOrder {
    int nM, nN, nwg, G, c;
    __device__ void init(int M, int N, int G_, int c_) { nM = M / BM; nN = N / BM; nwg = nM * nN; G = G_; c = c_; }
    __device__ bool map(long L, Unit& u) const {
        if (L >= nwg) return false;
        int wgid = (int)L; { const int q = nwg / NXCD, r = nwg % NXCD, xcd = wgid % NXCD, off = wgid / NXCD; wgid = (xcd < r ? xcd * (q + 1) : r * (q + 1) + (xcd - r) * q) + off; }
        const int nig = WGM * nN, gid = wgid / nig, fm = gid * WGM, gsz = (nM - fm) < WGM ? (nM - fm) : WGM;
        u.pm = fm + ((wgid % nig) % gsz); u.pn = (wgid % nig) / gsz; return true;
    }
    __device__ bool next(int i, Unit& u) const { return map((long)i * G + c, u); }
};
struct CtxOrder {
    int Gc, c;
    __device__ bool next(int i, Unit& u) const { const int j = i * Gc + c; if (j >= 48) return false; u.pm = 128 + j / 6; u.pn = 2 + j % 6; return true; }
};
template <int NT> struct S5Order {
    int G, c;
    __device__ void init(int G_, int c_) { G = G_; c = c_; }
    __device__ bool next(int i, Unit& u) const {
        const long L = (long)i * G + c; if (L >= 32 * NT) return false;
        const int g = (int)L / NT, t = (int)L % NT; u.pm = g * 9 + t; u.pn = g; return true;
    }
};

template <class Epi, class Sched, bool ALIGN_EPI = false, bool SP2 = true>
__device__ __forceinline__ void gemm_phase(LAS unsigned char* lds, const Gemm g, const Sched& S, const Epi& E) {
    const int tid = threadIdx.x, wid = __builtin_amdgcn_readfirstlane(tid >> 6), lane = tid & 63, wr = wid >> 2, wc = wid & 3, fr = lane & 15, fq = lane >> 4;
    const int K = g.K, nt = K / BK;
    unsigned voffA[2], voffB[2];
#pragma unroll
    for (int i = 0; i < 2; ++i) { int R, C; stage_rc(tid * 16 + i * 8192, R, C); const int Rb = Epi::PERM ? ((R & ~31) + perm32(R & 31)) : R;
        voffA[i] = (unsigned)(R * g.lda + C) * 2u; voffB[i] = (unsigned)(Rb * g.ldb + C) * 2u; }
    const size_t kstep = (size_t)(BK * 2);
    const size_t hstepA = (size_t)HALF * g.lda * 2, hstepB = (size_t)HALF * g.ldb * 2;
    const size_t tstepA = 2 * hstepA, tstepB = 2 * hstepB;
    const unsigned ldsw = (unsigned)wid * 1024u;
    const int aoff = lds_byte(wr * 64 + fr, fq * 8), boff = lds_byte(wc * 32 + fr, fq * 8);
#define PG8_SA(b, h) (((b) * 2 + (h)) * HTB)
#define PG8_SB(b, h) ((4 + (b) * 2 + (h)) * HTB)
#define PG8_STAGE(bufoff, gbase, voff) do { _Pragma("unroll") for (int _i = 0; _i < 2; ++_i) \
        __builtin_amdgcn_global_load_lds((const unsigned*)((const char*)(gbase) + (voff)[_i]), (LAS unsigned*)(lds + (bufoff) + ldsw + _i * 8192), 16, 0, 0); } while (0)
#define PG8_LDA(dst, b, h) do { _Pragma("unroll") for (int m = 0; m < 4; ++m) _Pragma("unroll") for (int k = 0; k < 2; ++k) dst[m][k] = *(const LAS bf16x8*)(lds + PG8_SA(b, h) + aoff + m * 2048 + k * 1024); } while (0)
#define PG8_LDB(dst, b, h) do { _Pragma("unroll") for (int n = 0; n < 2; ++n) _Pragma("unroll") for (int k = 0; k < 2; ++k) dst[n][k] = *(const LAS bf16x8*)(lds + PG8_SB(b, h) + boff + n * 2048 + k * 1024); } while (0)
#define PG8_MMA(ai, bj, At, Bt) do { __builtin_amdgcn_s_setprio(1); _Pragma("unroll") for (int m = 0; m < 4; ++m) _Pragma("unroll") for (int n = 0; n < 2; ++n) _Pragma("unroll") for (int k = 0; k < 2; ++k) \
        acc[ai][bj][m][n] = __builtin_amdgcn_mfma_f32_16x16x32_bf16(Bt[n][k], At[m][k], acc[ai][bj][m][n], 0, 0, 0); __builtin_amdgcn_s_setprio(0); } while (0)
#define PG8_WAIT_V(n) asm volatile("s_waitcnt vmcnt(" #n ")" ::: "memory")
#define PG8_WAIT_L(n) asm volatile("s_waitcnt lgkmcnt(" #n ")" ::: "memory")
#define PG8_BAR __builtin_amdgcn_s_barrier()
#define PG8_SCHED __builtin_amdgcn_sched_barrier(0)
    Unit cur, nxt; int ui = 0;
    if (!S.next(0, cur)) return;
    f32x4 acc[2][2][4][2];
#pragma unroll
    for (int a = 0; a < 2; ++a)
#pragma unroll
        for (int b = 0; b < 2; ++b)
#pragma unroll
            for (int m = 0; m < 4; ++m)
#pragma unroll
                for (int n = 0; n < 2; ++n) acc[a][b][m][n] = (f32x4){0.f, 0.f, 0.f, 0.f};
    bf16x8 At[4][2], B0[2][2], B1[2][2];
    const char* cA = (const char*)g.A + (size_t)cur.pm * tstepA; const char* cB = (const char*)g.Bt + (size_t)cur.pn * tstepB;
    if constexpr (SP2) {
        PG8_STAGE(PG8_SB(0, 0), cB, voffB); PG8_STAGE(PG8_SB(0, 1), cB + hstepB, voffB); PG8_STAGE(PG8_SA(0, 0), cA, voffA); PG8_STAGE(PG8_SA(0, 1), cA + hstepA, voffA);
        if (wr == 1) PG8_BAR;
        PG8_WAIT_V(2); PG8_BAR;
        PG8_STAGE(PG8_SB(1, 0), cB + kstep, voffB); PG8_STAGE(PG8_SA(1, 0), cA + kstep, voffA); PG8_STAGE(PG8_SB(1, 1), cB + hstepB + kstep, voffB);
        PG8_WAIT_V(6); PG8_BAR;
    } else {
        PG8_STAGE(PG8_SB(0, 0), cB, voffB); PG8_STAGE(PG8_SA(0, 0), cA, voffA); PG8_STAGE(PG8_SB(0, 1), cB + hstepB, voffB); PG8_STAGE(PG8_SA(0, 1), cA + hstepA, voffA);
        if (wr == 1) PG8_BAR;
        PG8_WAIT_V(4); PG8_BAR;
        PG8_STAGE(PG8_SB(1, 0), cB + kstep, voffB); PG8_STAGE(PG8_SA(1, 0), cA + kstep, voffA); PG8_STAGE(PG8_SB(1, 1), cB + hstepB + kstep, voffB);
        PG8_WAIT_V(6); PG8_BAR;
    }
    for (;;) {
        const bool has_next = S.next(ui + 1, nxt);
        const char* nA = has_next ? (const char*)g.A + (size_t)nxt.pm * tstepA : cA; const char* nB = has_next ? (const char*)g.Bt + (size_t)nxt.pn * tstepB : cB;
        for (int t = 0; t < nt; t += 2) {
            const bool last = (t == nt - 2);
            const char* a1 = cA + (size_t)(t + 1) * kstep;
            const char* a2 = last ? nA : cA + (size_t)(t + 2) * kstep; const char* b2 = last ? nB : cB + (size_t)(t + 2) * kstep;
            const char* a3 = a2 + kstep; const char* b3 = b2 + kstep;
            if constexpr (SP2) {
            PG8_LDB(B0, 0, 0); PG8_LDB(B1, 0, 1); PG8_SCHED; PG8_LDA(At, 0, 0); PG8_STAGE(PG8_SA(1, 1), a1 + hstepA, voffA);
            PG8_WAIT_V(8); PG8_WAIT_L(0); PG8_BAR; PG8_MMA(0, 0, At, B0); PG8_MMA(0, 1, At, B1); PG8_BAR; PG8_SCHED;
            PG8_LDA(At, 0, 1); PG8_STAGE(PG8_SB(0, 0), b2, voffB); PG8_STAGE(PG8_SB(0, 1), b2 + hstepB, voffB); PG8_STAGE(PG8_SA(0, 0), a2, voffA);
            PG8_WAIT_V(8); PG8_WAIT_L(0); PG8_BAR; PG8_MMA(1, 0, At, B0); PG8_MMA(1, 1, At, B1); PG8_BAR; PG8_SCHED;
            PG8_LDB(B0, 1, 0); PG8_LDB(B1, 1, 1); PG8_SCHED; PG8_LDA(At, 1, 0); PG8_STAGE(PG8_SA(0, 1), a2 + hstepA, voffA);
            PG8_WAIT_V(8); PG8_WAIT_L(0); PG8_BAR; PG8_MMA(0, 0, At, B0); PG8_MMA(0, 1, At, B1); PG8_BAR; PG8_SCHED;
            PG8_LDA(At, 1, 1); PG8_STAGE(PG8_SB(1, 0), b3, voffB); PG8_STAGE(PG8_SB(1, 1), b3 + hstepB, voffB); PG8_STAGE(PG8_SA(1, 0), a3, voffA);
            PG8_WAIT_V(8); PG8_WAIT_L(0); PG8_BAR; PG8_MMA(1, 0, At, B0); PG8_MMA(1, 1, At, B1); PG8_BAR; PG8_SCHED;
            } else {
            PG8_LDB(B0, 0, 0); PG8_SCHED; PG8_LDA(At, 0, 0); PG8_STAGE(PG8_SA(1, 1), a1 + hstepA, voffA);
            PG8_WAIT_L(8); PG8_BAR; PG8_WAIT_L(0); PG8_MMA(0, 0, At, B0); PG8_BAR; PG8_SCHED;
            PG8_LDB(B1, 0, 1); PG8_STAGE(PG8_SB(0, 0), b2, voffB);
            PG8_BAR; PG8_WAIT_L(0); PG8_MMA(0, 1, At, B1); PG8_BAR;
            PG8_LDA(At, 0, 1); PG8_STAGE(PG8_SA(0, 0), a2, voffA);
            PG8_BAR; PG8_WAIT_L(0); PG8_MMA(1, 0, At, B0); PG8_BAR; PG8_SCHED;
            PG8_STAGE(PG8_SB(0, 1), b2 + hstepB, voffB);
            PG8_WAIT_V(6); PG8_BAR; PG8_MMA(1, 1, At, B1); PG8_BAR;
            PG8_LDB(B0, 1, 0); PG8_SCHED; PG8_LDA(At, 1, 0); PG8_STAGE(PG8_SA(0, 1), a2 + hstepA, voffA);
            PG8_WAIT_L(8); PG8_BAR; PG8_WAIT_L(0); PG8_MMA(0, 0, At, B0); PG8_BAR; PG8_SCHED;
            PG8_LDB(B1, 1, 1); PG8_STAGE(PG8_SB(1, 0), b3, voffB);
            PG8_BAR; PG8_WAIT_L(0); PG8_MMA(0, 1, At, B1); PG8_BAR;
            PG8_LDA(At, 1, 1); PG8_STAGE(PG8_SA(1, 0), a3, voffA);
            PG8_BAR; PG8_WAIT_L(0); PG8_MMA(1, 0, At, B0); PG8_BAR; PG8_SCHED;
            PG8_STAGE(PG8_SB(1, 1), b3 + hstepB, voffB);
            PG8_WAIT_V(6); PG8_BAR; PG8_MMA(1, 1, At, B1); PG8_BAR;
                    }
        }
        if constexpr (ALIGN_EPI) { if (wr == 0) PG8_BAR; }
        E(acc, cur, wr, wc, fr, fq);
        if (!has_next) break;
#pragma unroll
        for (int a = 0; a < 2; ++a)
#pragma unroll
            for (int b = 0; b < 2; ++b)
#pragma unroll
                for (int m = 0; m < 4; ++m)
#pragma unroll
                    for (int n = 0; n < 2; ++n) acc[a][b][m][n] = (f32x4){0.f, 0.f, 0.f, 0.f};
        cur = nxt; cA = nA; cB = nB; ++ui;
        if constexpr (ALIGN_EPI) { if (wr == 1) PG8_BAR; }
    }
    PG8_WAIT_V(0);
    if constexpr (!ALIGN_EPI) { if (wr == 0) PG8_BAR; }
    PG8_BAR;
#undef PG8_SA
#undef PG8_SB
#undef PG8_STAGE
#undef PG8_LDA
#undef PG8_LDB
#undef PG8_MMA
#undef PG8_WAIT_V
#undef PG8_WAIT_L
#undef PG8_BAR
#undef PG8_SCHED
}
}
using pg8::Unit;

#define EPI_ROWS_BEGIN _Pragma("unroll") for (int ai = 0; ai < 2; ++ai) _Pragma("unroll") for (int m = 0; m < 4; ++m) {
#define EPI_ROWS_END }

struct EpiInProj {
    static constexpr bool PERM = true;
    bf16_t *q, *k, *vt, *vtc, *xh, *sig; const f32x2* rope;
    __device__ __forceinline__ void operator()(const f32x4 (&acc)[2][2][4][2], const Unit& u, int wr, int wc, int fr, int fq) const {
        const int pn = u.pn; const bool isctx = u.pm >= 128;
        const int kind = pn < 2 ? 0 : pn < 4 ? 1 : pn < 6 ? 2 : pn < 8 ? 3 : 4;
        EPI_ROWS_BEGIN
            const int r = u.pm * 256 + ai * 128 + wr * 64 + m * 16 + fr;
#pragma unroll
            for (int bj = 0; bj < 2; ++bj) {
                const int c = pn * 256 + bj * 128 + wc * 32 + 8 * fq;
                f32x4 v0 = acc[ai][bj][m][0], v1 = acc[ai][bj][m][1];
                if (kind <= 1) {
                    if (!isctx) {
                        const int t = r & 4095; const int pos = (wc & 1) ? (t & 63) : (t >> 6);
                        const f32x4* cs = (const f32x4*)(rope + pos * 16 + 8 * (fq & 1));
                        const f32x4 cs0 = cs[0], cs1 = cs[1], cs2 = cs[2], cs3 = cs[3];
                        const float sg = (fq >> 1) ? 1.0f : -1.0f;
                        f32x4 p0, p1;
#pragma unroll
                        for (int j = 0; j < 4; ++j) { p0[j] = __shfl_xor(v0[j], 32); p1[j] = __shfl_xor(v1[j], 32); }
                        v0[0] = v0[0] * cs0[0] + sg * p0[0] * cs0[1]; v0[1] = v0[1] * cs0[2] + sg * p0[1] * cs0[3];
                        v0[2] = v0[2] * cs1[0] + sg * p0[2] * cs1[1]; v0[3] = v0[3] * cs1[2] + sg * p0[3] * cs1[3];
                        v1[0] = v1[0] * cs2[0] + sg * p1[0] * cs2[1]; v1[1] = v1[1] * cs2[2] + sg * p1[1] * cs2[3];
                        v1[2] = v1[2] * cs3[0] + sg * p1[2] * cs3[1]; v1[3] = v1[3] * cs3[2] + sg * p1[3] * cs3[3];
                    }
                    u32x4 w; w.x = cvt_pk_bf16(v0[0], v0[1]); w.y = cvt_pk_bf16(v0[2], v0[3]); w.z = cvt_pk_bf16(v1[0], v1[1]); w.w = cvt_pk_bf16(v1[2], v1[3]);
                    bf16_t* dst = (kind == 0) ? (q + (size_t)r * 512 + c) : (k + (size_t)r * 512 + (c - 512));
                    *(u32x4*)dst = w;
                } else if (kind == 2) {
                    const int cv = c - 1024, h = cv >> 6, d0 = cv & 63;
                    bf16_t* dst;
                    if (!isctx) { const int b = r >> 12, t = r & 4095; dst = vt + ((size_t)((b * 8 + h) * 512 + (t >> 3))) * 512 + d0 * 8 + (t & 7); }
                    else { const int rc = r - MLAT, b = rc >> 8, mm = rc & 255; dst = vtc + ((size_t)((b * 8 + h) * 32 + (mm >> 3))) * 512 + d0 * 8 + (mm & 7); }
#pragma unroll
                    for (int j = 0; j < 4; ++j) { dst[8 * j] = f2bf(v0[j]); dst[8 * (4 + j)] = f2bf(v1[j]); }
                } else if (kind == 3) {
                    const int cu = c - 1536, g = cu >> 4, h0 = cu & 15;
                    size_t row; int col;
                    if (!isctx) { const int b = r >> 12, t = r & 4095; row = (size_t)g * XH_ROWS + b * 256 + (t >> 4); col = (t & 15) * 16 + h0; }
                    else { const int rc = r - MLAT, b = rc >> 8, mm = rc & 255; row = (size_t)g * XH_ROWS + 2048 + b * 16 + (mm >> 4); col = (mm & 15) * 16 + h0; }
                    u32x4 w; w.x = cvt_pk_bf16(v0[0], v0[1]); w.y = cvt_pk_bf16(v0[2], v0[3]); w.z = cvt_pk_bf16(v1[0], v1[1]); w.w = cvt_pk_bf16(v1[2], v1[3]);
                    *(u32x4*)(xh + row * 512 + col) = w;
                } else {
                    u32x4 w; w.x = cvt_pk_bf16(fast_sigmoid(v0[0]), fast_sigmoid(v0[1])); w.y = cvt_pk_bf16(fast_sigmoid(v0[2]), fast_sigmoid(v0[3]));
                    w.z = cvt_pk_bf16(fast_sigmoid(v1[0]), fast_sigmoid(v1[1])); w.w = cvt_pk_bf16(fast_sigmoid(v1[2]), fast_sigmoid(v1[3]));
                    *(u32x4*)(sig + (size_t)r * 2048 + (c - 2048)) = w;
                }
            }
        EPI_ROWS_END
    }
};

struct EpiE {
    static constexpr bool PERM = false;
    float* E;
    __device__ __forceinline__ void operator()(const f32x4 (&acc)[2][2][4][2], const Unit& u, int wr, int wc, int fr, int fq) const {
        EPI_ROWS_BEGIN
            const int r = u.pm * 256 + ai * 128 + wr * 64 + m * 16 + fr;
            float* rowp = E + (size_t)r * 256 + wc * 32 + 4 * fq;
#pragma unroll
            for (int bj = 0; bj < 2; ++bj)
#pragma unroll
                for (int n = 0; n < 2; ++n) *(f32x4*)(rowp + bj * 128 + n * 16) = acc[ai][bj][m][n];
        EPI_ROWS_END
    }
};

__device__ __forceinline__ float gelu_tanh(float x) {
    const float z = 1.5957691216057308f * (x + 0.044715f * x * x * x);
    return x * fast_sigmoid(z);
}

struct EpiY {
    static constexpr bool PERM = true;
    const bf16_t* xh; const float* dsk; bf16_t* y;
    __device__ __forceinline__ void operator()(const f32x4 (&acc)[2][2][4][2], const Unit& u, int wr, int wc, int fr, int fq) const {
        const int g = u.pn, it = u.pm - g * 9;
        const int rr0 = wr * 64 + fr, c00 = wc * 32 + 8 * fq, h0 = c00 & 15;
        u32x4 uu[2][4][2];
#pragma unroll
        for (int ai = 0; ai < 2; ++ai)
#pragma unroll
            for (int m = 0; m < 4; ++m)
#pragma unroll
                for (int bj = 0; bj < 2; ++bj) uu[ai][m][bj] = *(const u32x4*)(xh + ((size_t)u.pm * 256 + rr0 + ai * 128 + m * 16) * 512 + c00 + bj * 128);
        const f32x4 d0 = *(const f32x4*)(dsk + g * 16 + h0), d1 = *(const f32x4*)(dsk + g * 16 + h0 + 4);
        EPI_ROWS_BEGIN
            const int rr = rr0 + ai * 128 + m * 16;
            const int idx = it * 256 + rr, b = idx >> 8, cch = idx & 255;
#pragma unroll
            for (int bj = 0; bj < 2; ++bj) {
                const int t = (c00 + bj * 128) >> 4;
                const u32x4 w4 = uu[ai][m][bj];
                const f32x4 v0 = acc[ai][bj][m][0], v1 = acc[ai][bj][m][1];
                float o[8];
                o[0] = v0[0] + d0[0] * bflo(w4.x); o[1] = v0[1] + d0[1] * bfhi(w4.x); o[2] = v0[2] + d0[2] * bflo(w4.y); o[3] = v0[3] + d0[3] * bfhi(w4.y);
                o[4] = v1[0] + d1[0] * bflo(w4.z); o[5] = v1[1] + d1[1] * bfhi(w4.z); o[6] = v1[2] + d1[2] * bflo(w4.w); o[7] = v1[3] + d1[3] * bfhi(w4.w);
#pragma unroll
                for (int j = 0; j < 8; ++j) o[j] = gelu_tanh(o[j]);
                u32x4 w; w.x = cvt_pk_bf16(o[0], o[1]); w.y = cvt_pk_bf16(o[2], o[3]); w.z = cvt_pk_bf16(o[4], o[5]); w.w = cvt_pk_bf16(o[6], o[7]);
                *(u32x4*)(y + ((size_t)(b * 4096 + cch * 16 + t)) * 512 + g * 16 + h0) = w;
            }
        EPI_ROWS_END
    }
};

struct EpiGLU {
    static constexpr bool PERM = true;
    bf16_t* o; int ld;
    __device__ __forceinline__ void operator()(const f32x4 (&acc)[2][2][4][2], const Unit& u, int wr, int wc, int fr, int fq) const {
        EPI_ROWS_BEGIN
            const int r = u.pm * 256 + ai * 128 + wr * 64 + m * 16 + fr;
            const int oc = u.pn * 128 + wc * 32 + 8 * fq;
            const f32x4 a0 = acc[ai][0][m][0], a1 = acc[ai][0][m][1], g0 = acc[ai][1][m][0], g1 = acc[ai][1][m][1];
            u32x4 w; w.x = cvt_pk_bf16(a0[0] * fast_sigmoid(g0[0]), a0[1] * fast_sigmoid(g0[1])); w.y = cvt_pk_bf16(a0[2] * fast_sigmoid(g0[2]), a0[3] * fast_sigmoid(g0[3]));
            w.z = cvt_pk_bf16(a1[0] * fast_sigmoid(g1[0]), a1[1] * fast_sigmoid(g1[1])); w.w = cvt_pk_bf16(a1[2] * fast_sigmoid(g1[2]), a1[3] * fast_sigmoid(g1[3]));
            *(u32x4*)(o + (size_t)r * ld + oc) = w;
        EPI_ROWS_END
    }
};

template <int SECOND> struct EpiBranch {
    static constexpr bool PERM = true;
    const bf16_t* sig; bf16_t* mb;
    __device__ __forceinline__ void operator()(const f32x4 (&acc)[2][2][4][2], const Unit& u, int wr, int wc, int fr, int fq) const {
        const int r0 = u.pm * 256 + wr * 64 + fr, c00 = u.pn * 256 + wc * 32 + 8 * fq;
#pragma unroll
        for (int ai = 0; ai < 2; ++ai) {
            u32x4 sg[4][2], pv[4][2];
#pragma unroll
            for (int m = 0; m < 4; ++m)
#pragma unroll
                for (int bj = 0; bj < 2; ++bj) { const size_t r = (size_t)(r0 + ai * 128 + m * 16);
                    sg[m][bj] = *(const u32x4*)(sig + r * 2048 + c00 + bj * 128);
                    if (SECOND) pv[m][bj] = *(const u32x4*)(mb + r * 1024 + c00 + bj * 128); }
#pragma unroll
            for (int m = 0; m < 4; ++m)
#pragma unroll
                for (int bj = 0; bj < 2; ++bj) {
                    const u32x4 sv = sg[m][bj];
                    const f32x4 v0 = acc[ai][bj][m][0], v1 = acc[ai][bj][m][1];
                    float o[8];
                    o[0] = v0[0] * bflo(sv.x); o[1] = v0[1] * bfhi(sv.x); o[2] = v0[2] * bflo(sv.y); o[3] = v0[3] * bfhi(sv.y);
                    o[4] = v1[0] * bflo(sv.z); o[5] = v1[1] * bfhi(sv.z); o[6] = v1[2] * bflo(sv.w); o[7] = v1[3] * bfhi(sv.w);
                    if (SECOND) { const u32x4 pp = pv[m][bj];
                        o[0] += bflo(pp.x); o[1] += bfhi(pp.x); o[2] += bflo(pp.y); o[3] += bfhi(pp.y); o[4] += bflo(pp.z); o[5] += bfhi(pp.z); o[6] += bflo(pp.w); o[7] += bfhi(pp.w); }
                    u32x4 w; w.x = cvt_pk_bf16(o[0], o[1]); w.y = cvt_pk_bf16(o[2], o[3]); w.z = cvt_pk_bf16(o[4], o[5]); w.w = cvt_pk_bf16(o[6], o[7]);
                    *(u32x4*)(mb + (size_t)(r0 + ai * 128 + m * 16) * 1024 + c00 + bj * 128) = w;
                }
        }
    }
};

struct EpiWout {
    static constexpr bool PERM = true;
    const float* x; const float* mod; const float* gffn; bf16_t* out; bf16_t* ap; float* ss;
    __device__ __forceinline__ void operator()(const f32x4 (&acc)[2][2][4][2], const Unit& u, int wr, int wc, int fr, int fq) const {
        const int b = u.pm >> 4;
        const float* g1 = mod + b * 6144 + 2 * 1024; const float* sc2 = mod + b * 6144 + 4 * 1024;
        const int r0 = u.pm * 256 + wr * 64 + fr, c00 = u.pn * 256 + wc * 32 + 8 * fq;
        f32x4 gv[2][2], gs[2][2];
#pragma unroll
        for (int bj = 0; bj < 2; ++bj)
#pragma unroll
            for (int n = 0; n < 2; ++n) { const int c = c00 + bj * 128 + 4 * n; gv[bj][n] = *(const f32x4*)(g1 + c); gs[bj][n] = *(const f32x4*)(gffn + c) * (*(const f32x4*)(sc2 + c) + 1.0f); }
#pragma unroll
        for (int ai = 0; ai < 2; ++ai)
#pragma unroll
        for (int mh = 0; mh < 2; ++mh) {
            f32x4 xv[2][2][2];
#pragma unroll
            for (int m2 = 0; m2 < 2; ++m2)
#pragma unroll
                for (int bj = 0; bj < 2; ++bj)
#pragma unroll
                    for (int n = 0; n < 2; ++n) xv[m2][bj][n] = *(const f32x4*)(x + (size_t)(r0 + ai * 128 + (mh * 2 + m2) * 16) * 1024 + c00 + bj * 128 + 4 * n);
#pragma unroll
            for (int m2 = 0; m2 < 2; ++m2) { const int m = mh * 2 + m2;
                const size_t r = (size_t)(r0 + ai * 128 + m * 16);
                float sq = 0.f;
#pragma unroll
                for (int bj = 0; bj < 2; ++bj)
#pragma unroll
                    for (int n = 0; n < 2; ++n) {
                        const int c = c00 + bj * 128 + 4 * n;
                        const f32x4 h = xv[m2][bj][n] + gv[bj][n] * acc[ai][bj][m][n];
                        { u32x2 hw; hw.x = cvt_pk_bf16(h[0], h[1]); hw.y = cvt_pk_bf16(h[2], h[3]); *(u32x2*)(out + r * 1024 + c) = hw; }
                        sq += h[0] * h[0] + h[1] * h[1] + h[2] * h[2] + h[3] * h[3];
                        const f32x4 a = h * gs[bj][n];
                        u32x2 w; w.x = cvt_pk_bf16(a[0], a[1]); w.y = cvt_pk_bf16(a[2], a[3]);
                        *(u32x2*)(ap + r * 1024 + c) = w;
                    }
                sq = xsum16(xsum32(sq));
                if (fq == 0) ss[r * 16 + u.pn * 4 + wc] = sq;
            }
        }
    }
};

struct EpiFFNIn {
    static constexpr bool PERM = true;
    const float* ss; const float* bias2; bf16_t* hid;
    __device__ __forceinline__ void operator()(const f32x4 (&acc)[2][2][4][2], const Unit& u, int wr, int wc, int fr, int fq) const {
        const int b = u.pm >> 4;
        const int r0 = u.pm * 256 + wr * 64 + fr, c00 = u.pn * 256 + wc * 32 + 8 * fq, oc = u.pn * 128 + wc * 32 + 8 * fq;
        f32x4 sp[8], ba[2], bb[2];
#pragma unroll
        for (int i = 0; i < 8; ++i) sp[i] = *(const f32x4*)(ss + (size_t)(r0 + (i >> 2) * 128 + (i & 3) * 16) * 16 + 4 * fq);
#pragma unroll
        for (int n = 0; n < 2; ++n) { ba[n] = *(const f32x4*)(bias2 + b * 5632 + c00 + 4 * n); bb[n] = *(const f32x4*)(bias2 + b * 5632 + c00 + 128 + 4 * n); }
        float rstd[8];
#pragma unroll
        for (int i = 0; i < 8; ++i) { float t = (sp[i][0] + sp[i][1]) + (sp[i][2] + sp[i][3]); t = xsum16(xsum32(t)); rstd[i] = 1.0f / sqrtf(t * (1.0f / 1024.0f) + NORM_EPS); }
        EPI_ROWS_BEGIN
            const int r = r0 + ai * 128 + m * 16;
            u32x4 w;
#pragma unroll
            for (int n = 0; n < 2; ++n) {
                const f32x4 va = acc[ai][0][m][n] * rstd[ai * 4 + m] + ba[n], vb = acc[ai][1][m][n] * rstd[ai * 4 + m] + bb[n];
                const unsigned lo = cvt_pk_bf16(va[0] * fast_sigmoid(va[0]) * vb[0], va[1] * fast_sigmoid(va[1]) * vb[1]);
                const unsigned hi = cvt_pk_bf16(va[2] * fast_sigmoid(va[2]) * vb[2], va[3] * fast_sigmoid(va[3]) * vb[3]);
                if (n == 0) { w.x = lo; w.y = hi; } else { w.z = lo; w.w = hi; }
            }
            *(u32x4*)(hid + (size_t)r * FH + oc) = w;
        EPI_ROWS_END
    }
};

struct EpiFFNOut {
    static constexpr bool PERM = true;
    const float* mod; bf16_t* out; float* ss;
    __device__ __forceinline__ void operator()(const f32x4 (&acc)[2][2][4][2], const Unit& u, int wr, int wc, int fr, int fq) const {
        const int b = u.pm >> 4;
        const float* g2 = mod + b * 6144 + 5 * 1024;
        const int r0 = u.pm * 256 + wr * 64 + fr, c00 = u.pn * 256 + wc * 32 + 8 * fq;
        f32x4 gv[2][2];
#pragma unroll
        for (int bj = 0; bj < 2; ++bj)
#pragma unroll
            for (int n = 0; n < 2; ++n) gv[bj][n] = *(const f32x4*)(g2 + c00 + bj * 128 + 4 * n);
#pragma unroll
        for (int ai = 0; ai < 2; ++ai) {
            u32x2 hv[4][2][2];
#pragma unroll
            for (int m = 0; m < 4; ++m)
#pragma unroll
                for (int bj = 0; bj < 2; ++bj)
#pragma unroll
                    for (int n = 0; n < 2; ++n) hv[m][bj][n] = *(const u32x2*)(out + (size_t)(r0 + ai * 128 + m * 16) * 1024 + c00 + bj * 128 + 4 * n);
#pragma unroll
            for (int m = 0; m < 4; ++m) {
                const size_t r = (size_t)(r0 + ai * 128 + m * 16);
                float sq = 0.f;
#pragma unroll
                for (int bj = 0; bj < 2; ++bj)
#pragma unroll
                    for (int n = 0; n < 2; ++n) {
                        const u32x2 hq = hv[m][bj][n];
                        const f32x4 h = (f32x4){bflo(hq.x), bfhi(hq.x), bflo(hq.y), bfhi(hq.y)} + gv[bj][n] * acc[ai][bj][m][n];
                        { u32x2 hw; hw.x = cvt_pk_bf16(h[0], h[1]); hw.y = cvt_pk_bf16(h[2], h[3]); *(u32x2*)(out + r * 1024 + c00 + bj * 128 + 4 * n) = hw; }
                        sq += h[0] * h[0] + h[1] * h[1] + h[2] * h[2] + h[3] * h[3];
                    }
                sq = xsum16(xsum32(sq));
                if (fq == 0) ss[r * 16 + u.pn * 4 + wc] = sq;
            }
        }
    }
};

struct Params {
    const float *x, *c, *ctx, *c_ctx, *w_mod, *b_mod, *attn_g, *ffn_g, *w_in, *rpb, *lam_re, *lam_im, *log_dt, *b_re, *b_im, *c_re, *c_im, *ssm_d,
        *w_glu, *w_ba, *w_bs, *w_out, *w_fi, *w_fo, *final_g;
    float* out; unsigned char* ws;
    int ph_lo, ph_hi;
};

__device__ __forceinline__ void sincos_d(double a, float& s, float& c) {
    const double inv2pi = 0.15915494309189533577, twopi = 6.283185307179586477;
    double x = a - twopi * __builtin_rint(a * inv2pi);
    const double x2 = x * x;
    double ts = 1.0, tc = 1.0;
    ts = 1.0; tc = 1.0;
#pragma unroll
    for (int k = 13; k >= 1; --k) { ts = 1.0 - x2 * ts * (1.0 / (double)((2 * k) * (2 * k + 1))); tc = 1.0 - x2 * tc * (1.0 / (double)((2 * k - 1) * (2 * k))); }
    s = (float)(x * ts); c = (float)tc;
}

__device__ void tr_strip(const float* __restrict__ src, int N, int K, int ks, int nt, bf16_t* __restrict__ dst, int half, unsigned short* T) {
    const int tid = threadIdx.x;
    { const int n = tid & 63, kb = tid >> 6; float v[32];
      const float* sp = src + (size_t)(ks * 256 + kb) * N + nt * 64 + n;
#pragma unroll
      for (int i = 0; i < 32; ++i) v[i] = sp[(size_t)(8 * i) * N];
#pragma unroll
      for (int i = 0; i < 32; ++i) T[(kb + 8 * i) * 66 + n] = f2bf(v[i]); }
    __syncthreads();
    { const int nn = tid >> 3, kc = (tid & 7) * 8; const int ncol = nt * 64 + nn;
      int drow = ncol;
      if (half) drow = ncol < half ? ((ncol >> 7) * 256 + (ncol & 127)) : (((ncol - half) >> 7) * 256 + 128 + ((ncol - half) & 127));
#pragma unroll
      for (int q = 0; q < 4; ++q) { const int kk = q * 64 + kc; unsigned short v[8];
#pragma unroll
        for (int j = 0; j < 8; ++j) v[j] = T[(kk + j) * 66 + nn];
        u32x4 w; w.x = v[0] | ((unsigned)v[1] << 16); w.y = v[2] | ((unsigned)v[3] << 16); w.z = v[4] | ((unsigned)v[5] << 16); w.w = v[6] | ((unsigned)v[7] << 16);
        *(u32x4*)(dst + (size_t)drow * K + ks * 256 + kk) = w; } }
    __syncthreads();
}

template <int NR>
__device__ void gemv_tile(const float* __restrict__ W, int N, int n0, const float* A_lds, float* red, float (&res)[2], int (&ridx)[2]) {
    const int tid = threadIdx.x, col = tid & 63, ks = tid >> 6;
    float acc[NR];
#pragma unroll
    for (int r = 0; r < NR; ++r) acc[r] = 0.f;
    const float* wp = W + (size_t)(ks * 128) * N + n0 + col;
#pragma unroll 16
    for (int k = 0; k < 128; ++k) { const float w = wp[(size_t)k * N];
#pragma unroll
        for (int r = 0; r < NR; ++r) acc[r] += A_lds[r * 1024 + ks * 128 + k] * w; }
#pragma unroll
    for (int r = 0; r < NR; ++r) red[(ks * NR + r) * 64 + col] = acc[r];
    __syncthreads();
#pragma unroll
    for (int e = 0; e < 2; ++e) { const int idx = tid + e * 512; ridx[e] = idx; float s = 0.f;
        if (idx < NR * 64) { const int r = idx >> 6, cc = idx & 63;
#pragma unroll
            for (int k8 = 0; k8 < 8; ++k8) s += red[(k8 * NR + r) * 64 + cc]; }
        res[e] = s; }
    __syncthreads();
}

__device__ void s5_build(const Params& P, int g, float* L) {
    float* lbp = L; float* Bb = L + 4352; float* Cc = L + 8448; float* Kt = L + 12544;
    const int tid = threadIdx.x;
#pragma unroll 5
    for (int idx = tid; idx < 2 * 17 * 64; idx += 512) {
        const int p = idx & 63, d = (idx >> 6) % 17, dir = idx / (17 * 64);
        const float dt = expf(P.log_dt[dir * 32 + g]);
        const float lr = P.lam_re[(dir * 32 + g) * 64 + p], li = P.lam_im[(dir * 32 + g) * 64 + p];
        const float mag = expf(lr * dt * (float)d); float s, c; sincos_d((double)li * (double)dt * (double)d, s, c);
        lbp[((dir * 17 + d) * 64 + p) * 2] = mag * c; lbp[((dir * 17 + d) * 64 + p) * 2 + 1] = mag * s;
    }
#pragma unroll 4
    for (int idx = tid; idx < 2 * 16 * 64; idx += 512) {
        const int p = idx & 63, h = (idx >> 6) & 15, dir = idx >> 10;
        Cc[((dir * 64 + p) * 16 + h) * 2] = P.c_re[((dir * 32 + g) * 16 + h) * 64 + p]; Cc[((dir * 64 + p) * 16 + h) * 2 + 1] = P.c_im[((dir * 32 + g) * 16 + h) * 64 + p];
    }
    __syncthreads();
#pragma unroll 4
    for (int idx = tid; idx < 2 * 64 * 16; idx += 512) {
        const int h = idx & 15, p = (idx >> 4) & 63, dir = idx >> 10;
        const float lr = P.lam_re[(dir * 32 + g) * 64 + p], li = P.lam_im[(dir * 32 + g) * 64 + p];
        const float nr = lbp[((dir * 17 + 1) * 64 + p) * 2] - 1.0f, ni = lbp[((dir * 17 + 1) * 64 + p) * 2 + 1];
        const float den = lr * lr + li * li;
        const float fre = (nr * lr + ni * li) / den, fim = (ni * lr - nr * li) / den;
        const float br = P.b_re[((dir * 32 + g) * 64 + p) * 16 + h], bi = P.b_im[((dir * 32 + g) * 64 + p) * 16 + h];
        Bb[((dir * 64 + p) * 16 + h) * 2] = fre * br - fim * bi; Bb[((dir * 64 + p) * 16 + h) * 2 + 1] = fre * bi + fim * br;
    }
    if (tid < 128) { const int p = tid & 63, dir = tid >> 6;
        ((f32x2*)(P.ws + WS_LBT))[(dir * 32 + g) * 64 + p] = (f32x2){lbp[((dir * 17 + 16) * 64 + p) * 2], lbp[((dir * 17 + 16) * 64 + p) * 2 + 1]}; }
    __syncthreads();
    { const int h = tid & 15, d = (tid >> 4) & 15, dir = tid >> 8;
      float ak[16];
#pragma unroll
      for (int j = 0; j < 16; ++j) ak[j] = 0.f;
      for (int p = 0; p < 64; ++p) {
          const f32x2 cc = *(const f32x2*)(Cc + ((dir * 64 + p) * 16 + h) * 2), zz = *(const f32x2*)(lbp + ((dir * 17 + d) * 64 + p) * 2);
          const float czr = cc.x * zz.x - cc.y * zz.y, czi = cc.x * zz.y + cc.y * zz.x;
          const f32x4* bp = (const f32x4*)(Bb + (dir * 64 + p) * 32);
#pragma unroll
          for (int j4 = 0; j4 < 8; ++j4) { const f32x4 bq = bp[j4]; ak[2 * j4] += czr * bq[0] - czi * bq[1]; ak[2 * j4 + 1] += czr * bq[2] - czi * bq[3]; }
      }
#pragma unroll
      for (int j = 0; j < 16; ++j) Kt[((dir * 16 + d) * 16 + h) * 16 + j] = ak[j]; }
    __syncthreads();
    bf16_t* W1 = (bf16_t*)(P.ws + WS_S5W1) + (size_t)g * 256 * 256;
    for (int v = tid; v < 256 * 32; v += 512) {
        const int n = v >> 5, k0 = (v & 31) * 8, dir = n >> 7, p = (n >> 1) & 63, ri = n & 1, s = k0 >> 4, h0 = k0 & 15;
        const int d = dir ? s : 15 - s;
        const float zr = lbp[((dir * 17 + d) * 64 + p) * 2], zi = lbp[((dir * 17 + d) * 64 + p) * 2 + 1];
        float o[8];
#pragma unroll
        for (int j = 0; j < 8; ++j) { const float br = Bb[((dir * 64 + p) * 16 + h0 + j) * 2], bi = Bb[((dir * 64 + p) * 16 + h0 + j) * 2 + 1];
            o[j] = ri ? (zr * bi + zi * br) : (zr * br - zi * bi); }
        u32x4 w; w.x = cvt_pk_bf16(o[0], o[1]); w.y = cvt_pk_bf16(o[2], o[3]); w.z = cvt_pk_bf16(o[4], o[5]); w.w = cvt_pk_bf16(o[6], o[7]);
        *(u32x4*)(W1 + (size_t)n * 256 + k0) = w;
    }
    bf16_t* M2 = (bf16_t*)(P.ws + WS_S5M2) + (size_t)g * 256 * 512;
    for (int v = tid; v < 256 * 64; v += 512) {
        const int n = v & 255, k0 = (v >> 8) * 8, t = n >> 4, h = n & 15;
        float o[8];
        if (k0 < 256) { const int s = k0 >> 4, h0 = k0 & 15;
#pragma unroll
            for (int j = 0; j < 8; ++j) { float a = 0.f;
                if (s <= t) a += Kt[((0 * 16 + (t - s)) * 16 + h) * 16 + h0 + j];
                if (s >= t) a += Kt[((1 * 16 + (s - t)) * 16 + h) * 16 + h0 + j];
                o[j] = a; }
        } else { const int dir = (k0 - 256) >> 7, kk = (k0 - 256) & 127, d = dir ? 16 - t : t + 1;
#pragma unroll
            for (int j = 0; j < 8; ++j) { const int p = (kk + j) >> 1, ri = (kk + j) & 1;
                const float cr = Cc[((dir * 64 + p) * 16 + h) * 2], ci = Cc[((dir * 64 + p) * 16 + h) * 2 + 1];
                const float zr = lbp[((dir * 17 + d) * 64 + p) * 2], zi = lbp[((dir * 17 + d) * 64 + p) * 2 + 1];
                o[j] = ri ? -(cr * zi + ci * zr) : (cr * zr - ci * zi); }
        }
        u32x4 w; w.x = cvt_pk_bf16(o[0], o[1]); w.y = cvt_pk_bf16(o[2], o[3]); w.z = cvt_pk_bf16(o[4], o[5]); w.w = cvt_pk_bf16(o[6], o[7]);
        *(u32x4*)(M2 + (size_t)n * 512 + k0) = w;
    }
    __syncthreads();
}

__device__ __forceinline__ void norm_rows2(const Params& P, int rowa, int rowb, int lane) {
    const float* mod = (const float*)(P.ws + WS_MOD);
    bf16_t* nb = (bf16_t*)(P.ws + WS_A);
    const int rows[2] = {rowa, rowb};
    f32x4 v[2][4];
#pragma unroll
    for (int q = 0; q < 2; ++q) { const int row = rows[q];
        const float* src = row < MLAT ? P.x + (size_t)row * 1024 : P.ctx + (size_t)(row - MLAT) * 1024;
#pragma unroll
        for (int i = 0; i < 4; ++i) v[q][i] = __builtin_nontemporal_load((const f32x4*)(src + 4 * lane + 256 * i)); }
#pragma unroll
    for (int q = 0; q < 2; ++q) { const int row = rows[q];
        const int mr = row < MLAT ? (row >> 12) : 8;
        const float* sh = mod + mr * 6144; const float* sc = sh + 1024;
        float ss = 0.f;
#pragma unroll
        for (int i = 0; i < 4; ++i) ss += v[q][i][0] * v[q][i][0] + v[q][i][1] * v[q][i][1] + v[q][i][2] * v[q][i][2] + v[q][i][3] * v[q][i][3];
#pragma unroll
        for (int o = 32; o >= 1; o >>= 1) ss += __shfl_xor(ss, o);
        const float rstd = 1.0f / sqrtf(ss * (1.0f / 1024.0f) + NORM_EPS);
#pragma unroll
        for (int i = 0; i < 4; ++i) { const int c = 4 * lane + 256 * i;
            const f32x4 gv = *(const f32x4*)(P.attn_g + c), sv = *(const f32x4*)(sc + c), hv = *(const f32x4*)(sh + c);
            const f32x4 o = v[q][i] * rstd * gv * (sv + 1.0f) + hv;
            u32x2 w; w.x = cvt_pk_bf16(o[0], o[1]); w.y = cvt_pk_bf16(o[2], o[3]);
            *(u32x2*)(nb + (size_t)row * 1024 + c) = w; } }
}

struct TrDesc { const float* src; bf16_t* dst; int N, K, half, nstrip_k, nitems; };

__device__ void phase0(const Params& P, unsigned char* lds) {
    const int tid = threadIdx.x;
    float* Lf = (float*)lds;
    int* qslot = (int*)(lds + 100 * 1024);
    unsigned* queue = (unsigned*)(P.ws + WS_BAR) + 64;
    TrDesc td[7] = {
        {P.w_in, (bf16_t*)(P.ws + WS_WIN), INC, DM, 0, DM / 256, (INC / 64) * (DM / 256)},
        {P.w_glu, (bf16_t*)(P.ws + WS_WGLU), 2 * SW, SW, SW, SW / 256, ((2 * SW) / 64) * (SW / 256)},
        {P.w_ba, (bf16_t*)(P.ws + WS_WBA), DM, AW, 0, AW / 256, (DM / 64) * (AW / 256)},
        {P.w_bs, (bf16_t*)(P.ws + WS_WBS), DM, SW, 0, SW / 256, (DM / 64) * (SW / 256)},
        {P.w_out, (bf16_t*)(P.ws + WS_WOUT), DM, DM, 0, DM / 256, (DM / 64) * (DM / 256)},
        {P.w_fi, (bf16_t*)(P.ws + WS_WFI), 2 * FH, DM, FH, DM / 256, ((2 * FH) / 64) * (DM / 256)},
        {P.w_fo, (bf16_t*)(P.ws + WS_WFO), DM, FH, 0, FH / 256, (DM / 64) * (FH / 256)}};
    int ntr = 0;
#pragma unroll
    for (int i = 0; i < 7; ++i) ntr += td[i].nitems;
    const int NI = 32 + 96 + 1 + ntr + 128;
    unsigned* modcnt = (unsigned*)(P.ws + WS_BAR) + 128;
    for (;;) {
        __syncthreads();
        if (tid == 0) *qslot = (int)atomicAdd(queue, 1u);
        __syncthreads();
        const int it = *qslot;
        if (it >= NI) break;
        if (it >= 32 && it < 64) {
            s5_build(P, it - 32, Lf);
        } else if (it < 128) {
            const int mt = it < 32 ? it : it - 32;
            for (int idx = tid; idx < 9 * 1024; idx += 512) { const float v = idx < 8192 ? P.c[idx] : P.c_ctx[idx - 8192]; Lf[idx] = v * fast_sigmoid(v); }
            __syncthreads();
            float res[2]; int ridx[2];
            gemv_tile<9>(P.w_mod, 6 * DM, mt * 64, Lf, Lf + 9 * 1024, res, ridx);
#pragma unroll
            for (int e = 0; e < 2; ++e) if (ridx[e] < 9 * 64) { const int r = ridx[e] >> 6, cc = ridx[e] & 63; ((float*)(P.ws + WS_MOD))[r * 6144 + mt * 64 + cc] = res[e] + P.b_mod[mt * 64 + cc]; }
            if (mt < 32) {
                asm volatile("s_waitcnt vmcnt(0)" ::: "memory"); __syncthreads();
                if (tid == 0) { __builtin_amdgcn_fence(__ATOMIC_RELEASE, "agent"); asm volatile("s_waitcnt vmcnt(0)" ::: "memory");
                    __hip_atomic_fetch_add(modcnt, 1u, __ATOMIC_RELAXED, __HIP_MEMORY_SCOPE_AGENT); }
            }
        } else if (it == 128) {
            for (int idx = tid; idx < 1024; idx += 512) { const int pos = idx >> 4, i = idx & 15;
                const float invf = expf(-(float)i * (1.0f / 16.0f) * 9.210340371976184f);
                float sn, cs; sincos_d((double)((float)pos * invf), sn, cs);
                ((f32x2*)(P.ws + WS_ROPE))[idx] = (f32x2){cs, sn}; }
        } else if (it >= 129 + ntr) {
            if (tid == 0) { unsigned spins = 0;
                while (__hip_atomic_load(modcnt, __ATOMIC_RELAXED, __HIP_MEMORY_SCOPE_AGENT) < 32u) { __builtin_amdgcn_s_sleep(4); if (++spins > (1u << 22)) break; }
                __builtin_amdgcn_fence(__ATOMIC_ACQUIRE, "agent"); asm volatile("s_waitcnt vmcnt(0)" ::: "memory"); }
            __syncthreads();
            const int base = MLAT + (it - 129 - ntr) * 16, wave = tid >> 6;
            norm_rows2(P, base + wave, base + 8 + wave, tid & 63);
        } else {
            int j = it - 129, w = 0;
#pragma unroll
            for (int i = 0; i < 6; ++i) if (w == i && j >= td[i].nitems) { j -= td[i].nitems; w = i + 1; }
            const float* src = td[0].src; bf16_t* dst = td[0].dst; int N = td[0].N, K = td[0].K, half = td[0].half, nk = td[0].nstrip_k;
#pragma unroll
            for (int i = 1; i < 7; ++i) if (w == i) { src = td[i].src; dst = td[i].dst; N = td[i].N; K = td[i].K; half = td[i].half; nk = td[i].nstrip_k; }
            tr_strip(src, N, K, j % nk, j / nk, dst, half, (unsigned short*)lds);
        }
    }
}

__device__ void phase1(const Params& P, unsigned char* lds) {
    const int tid = threadIdx.x, G = gridDim.x, lane = tid & 63, wave = tid >> 6;
    float* Lf = (float*)lds;
    const float* mod = (const float*)(P.ws + WS_MOD);
    for (int it = blockIdx.x; it < 88; it += G) {
        for (int idx = tid; idx < 8 * 1024; idx += 512) Lf[idx] = mod[(idx >> 10) * 6144 + 3 * 1024 + (idx & 1023)];
        __syncthreads();
        float res[2]; int ridx[2];
        gemv_tile<8>(P.w_fi, 2 * FH, it * 64, Lf, Lf + 8 * 1024, res, ridx);
        if (ridx[0] < 8 * 64) { const int r = ridx[0] >> 6, ncol = it * 64 + (ridx[0] & 63);
            const int drow = ncol < FH ? ((ncol >> 7) * 256 + (ncol & 127)) : (((ncol - FH) >> 7) * 256 + 128 + ((ncol - FH) & 127));
            ((float*)(P.ws + WS_BIAS2))[r * 5632 + drow] = res[0]; }
    }
    const int NBR = G > 96 ? G - 48 : G;
    for (int row0 = blockIdx.x * 8 + wave; row0 < MLAT; row0 += NBR * 16) {
        const int rb = row0 + NBR * 8;
        norm_rows2(P, row0, rb < MLAT ? rb : row0, lane);
    }
}

__device__ __forceinline__ void scan_task(const Params& P, int task, int lane) {
    const int g = task >> 4, dir = (task >> 3) & 1, b = task & 7, p = lane;
    const f32x2 lb = ((const f32x2*)(P.ws + WS_LBT))[(dir * 32 + g) * 64 + p];
    const float* __restrict__ Eg = (const float*)(P.ws + WS_E) + (size_t)g * XH_ROWS * 256 + dir * 128 + 2 * p;
    unsigned* __restrict__ xh = (unsigned*)((bf16_t*)(P.ws + WS_D) + (size_t)g * XH_ROWS * 512 + 256 + dir * 128 + 2 * p);
    float hr = 0.f, hi = 0.f;
    f32x2 e[16];
#pragma unroll
    for (int i = 0; i < 16; ++i) { const int cc = dir ? 15 - i : i; e[i] = *(const f32x2*)(Eg + (size_t)(2048 + b * 16 + cc) * 256); }
#pragma unroll
    for (int i = 0; i < 16; ++i) { const float nr = lb.x * hr - lb.y * hi + e[i].x, ni = lb.x * hi + lb.y * hr + e[i].y; hr = nr; hi = ni; }
    f32x2 en[32];
#pragma unroll
    for (int i = 0; i < 32; ++i) { const int c = dir ? 255 - i : i; en[i] = *(const f32x2*)(Eg + (size_t)(b * 256 + c) * 256); }
#pragma unroll 1
    for (int blk = 0; blk < 8; ++blk) {
        f32x2 ec[32];
#pragma unroll
        for (int i = 0; i < 32; ++i) ec[i] = en[i];
        if (blk < 7) {
#pragma unroll
            for (int i = 0; i < 32; ++i) { const int ci = (blk + 1) * 32 + i; const int c = dir ? 255 - ci : ci; en[i] = *(const f32x2*)(Eg + (size_t)(b * 256 + c) * 256); }
        }
#pragma unroll
        for (int i = 0; i < 32; ++i) { const int ci = blk * 32 + i; const int c = dir ? 255 - ci : ci;
            xh[(size_t)(b * 256 + c) * 256] = cvt_pk_bf16(hr, hi);
            const float nr = lb.x * hr - lb.y * hi + ec[i].x, ni = lb.x * hi + lb.y * hr + ec[i].y; hr = nr; hi = ni; }
    }
}

constexpr int ATT_LK = 0, ATT_LV = 256 * 144, ATT_LB = ATT_LV + 32768, ATT_LC = ATT_LB + 2048;

template <bool LOC>
__device__ __forceinline__ void att_softmax_pv(f32x4 (&s)[4], const bf16x8 (&vv)[2][4], f32x4 (&o)[5], float& mrun,
                                               const float* rpbl, const int (&dcl)[8], unsigned inw, int drbase) {
    const float SC = 0.125f * LOG2E;
    float mnew;
    if (LOC) {
        float mx = -1e30f;
#pragma unroll
        for (int tile = 0; tile < 4; ++tile) { const int dr = drbase + (tile >> 1);
#pragma unroll
            for (int j = 0; j < 4; ++j) { const int jj = 4 * (tile & 1) + j;
                const float bv = rpbl[dr * 31 + dcl[jj]];
                const float tv = __builtin_fmaf(s[tile][j], SC, bv);
                const float v = ((inw >> jj) & 1u) ? tv : -1e30f;
                s[tile][j] = v; mx = fmaxf(mx, v); } }
        mx = xmax16(xmax32(mx));
        mnew = fmaxf(mrun, mx);
#pragma unroll
        for (int tile = 0; tile < 4; ++tile)
#pragma unroll
            for (int j = 0; j < 4; ++j) s[tile][j] = __builtin_amdgcn_exp2f(s[tile][j] - mnew);
    } else {
        float mx = -1e30f;
#pragma unroll
        for (int tile = 0; tile < 4; ++tile)
#pragma unroll
            for (int j = 0; j < 4; ++j) mx = fmaxf(mx, s[tile][j]);
        mx = xmax16(xmax32(mx)) * SC;
        mnew = fmaxf(mrun, mx);
#pragma unroll
        for (int tile = 0; tile < 4; ++tile)
#pragma unroll
            for (int j = 0; j < 4; ++j) s[tile][j] = __builtin_amdgcn_exp2f(__builtin_fmaf(s[tile][j], SC, -mnew));
    }
    if (__builtin_amdgcn_ballot_w64(mnew > mrun) != 0ull) {
        const float alpha = __builtin_amdgcn_exp2f(mrun - mnew);
#pragma unroll
        for (int d = 0; d < 5; ++d) o[d] *= alpha;
    }
    mrun = mnew;
    const bf16x8 ones = {(short)0x3F80, (short)0x3F80, (short)0x3F80, (short)0x3F80, (short)0x3F80, (short)0x3F80, (short)0x3F80, (short)0x3F80};
#pragma unroll
    for (int kb2 = 0; kb2 < 2; ++kb2) {
        u32x4 pw; pw.x = cvt_pk_bf16(s[2 * kb2][0], s[2 * kb2][1]); pw.y = cvt_pk_bf16(s[2 * kb2][2], s[2 * kb2][3]);
        pw.z = cvt_pk_bf16(s[2 * kb2 + 1][0], s[2 * kb2 + 1][1]); pw.w = cvt_pk_bf16(s[2 * kb2 + 1][2], s[2 * kb2 + 1][3]);
        bf16x8 pb; __builtin_memcpy(&pb, &pw, 16);
#pragma unroll
        for (int d = 0; d < 4; ++d) o[d] = __builtin_amdgcn_mfma_f32_16x16x32_bf16(vv[kb2][d], pb, o[d], 0, 0, 0);
        o[4] = __builtin_amdgcn_mfma_f32_16x16x32_bf16(ones, pb, o[4], 0, 0, 0);
    }
}

__device__ __forceinline__ void attn_task(const Params& P, int b, int h, int r, int cb, int lane, const float* rpbl, const LAS unsigned char* ldsl) {
    const int n = lane & 15, g4 = lane >> 4;
    const bf16_t* qb = (const bf16_t*)(P.ws + WS_B);
    const bf16_t* kb = (const bf16_t*)(P.ws + WS_C);
    const bf16_t* vt = kb + (size_t)MALL * 512;
    bf16_t* ab = (bf16_t*)(P.ws + WS_A);
    const int tq = r * 64 + cb * 16 + n;
    const bf16_t* qp = qb + ((size_t)(b * 4096 + tq)) * 512 + h * 64 + 8 * g4;
    const bf16x8 q0 = *(const bf16x8*)qp, q1 = *(const bf16x8*)(qp + 32);
    const int rs = min(max(r - 4, 0), 56), bs = min(max(16 * cb - 8, 0), 32);
    const int qcol = 16 * cb + n, cst = min(max(qcol - 8, 0), 48);
    int dcl[8]; unsigned inw = 0;
#pragma unroll
    for (int jj = 0; jj < 8; ++jj) { const int kcol = bs + 8 * g4 + jj; if (kcol >= cst && kcol < cst + 16) inw |= 1u << jj; dcl[jj] = min(max(kcol - qcol, -15), 15) + 15; }
    f32x4 o[5];
#pragma unroll
    for (int d = 0; d < 5; ++d) o[d] = (f32x4){0.f, 0.f, 0.f, 0.f};
    float mrun = -1e30f;
    const int kx = 8 * (n >> 2) + (n & 3);
    const bf16_t* kloc = kb + ((size_t)b * 4096 + rs * 64 + bs + kx) * 512 + h * 64 + 8 * g4;
    const bf16_t* vloc = vt + ((size_t)(b * 8 + h) * 512 + (rs * 64 + bs) / 8 + g4) * 512 + n * 8;
    bf16x8 kc[4][2], kn[4][2], vv[2][4];
#define ATT_LOADK(dst, st) do { _Pragma("unroll") for (int tile = 0; tile < 4; ++tile) { \
        const bf16_t* kp_ = kloc + (size_t)(2 * (st) + (tile >> 1)) * (64 * 512) + (tile & 1) * (4 * 512); \
        dst[tile][0] = *(const bf16x8*)kp_; dst[tile][1] = *(const bf16x8*)(kp_ + 32); } } while (0)
    ATT_LOADK(kc, 0);
#pragma unroll
    for (int kb2 = 0; kb2 < 2; ++kb2)
#pragma unroll
        for (int d = 0; d < 4; ++d) vv[kb2][d] = *(const bf16x8*)(vloc + (size_t)kb2 * (8 * 512) + d * 128);
    const LAS unsigned char* lk = ldsl + ATT_LK + kx * 144 + g4 * 16;
    const LAS unsigned char* lv = ldsl + ATT_LV + (g4 * 64 + n) * 16;
#pragma unroll
    for (int step = 0; step < 4; ++step) {
        f32x4 s[4]; bf16x8 vl[2][4];
#pragma unroll
        for (int tile = 0; tile < 4; ++tile) {
            const LAS unsigned char* kp = lk + (2 * step + (tile >> 1)) * (32 * 144) + (tile & 1) * (4 * 144);
            const bf16x8 k0 = *(const LAS bf16x8*)kp, k1 = *(const LAS bf16x8*)(kp + 64);
            s[tile] = __builtin_amdgcn_mfma_f32_16x16x32_bf16(k0, q0, (f32x4){0.f, 0.f, 0.f, 0.f}, 0, 0, 0);
            s[tile] = __builtin_amdgcn_mfma_f32_16x16x32_bf16(k1, q1, s[tile], 0, 0, 0);
        }
#pragma unroll
        for (int kb2 = 0; kb2 < 2; ++kb2)
#pragma unroll
            for (int d = 0; d < 4; ++d) vl[kb2][d] = *(const LAS bf16x8*)(lv + (2 * step + kb2) * 4096 + d * 256);
        att_softmax_pv<false>(s, vl, o, mrun, rpbl, dcl, inw, 0);
    }
#pragma unroll 1
    for (int step = 0; step < 4; ++step) {
        if (step > 0) {
#pragma unroll
            for (int kb2 = 0; kb2 < 2; ++kb2) {
                const bf16_t* vp = vloc + (size_t)(2 * step + kb2) * (8 * 512);
#pragma unroll
                for (int d = 0; d < 4; ++d) vv[kb2][d] = *(const bf16x8*)(vp + d * 128);
            }
        }
        if (step < 3) ATT_LOADK(kn, step + 1);
        f32x4 s[4];
#pragma unroll
        for (int tile = 0; tile < 4; ++tile) {
            s[tile] = __builtin_amdgcn_mfma_f32_16x16x32_bf16(kc[tile][0], q0, (f32x4){0.f, 0.f, 0.f, 0.f}, 0, 0, 0);
            s[tile] = __builtin_amdgcn_mfma_f32_16x16x32_bf16(kc[tile][1], q1, s[tile], 0, 0, 0);
        }
        att_softmax_pv<true>(s, vv, o, mrun, rpbl, dcl, inw, rs + 2 * step - r + 7);
#pragma unroll
        for (int tile = 0; tile < 4; ++tile) { kc[tile][0] = kn[tile][0]; kc[tile][1] = kn[tile][1]; }
    }
#undef ATT_LOADK
    const float inv = 1.0f / o[4][0];
    bf16_t* op = ab + ((size_t)(b * 4096 + tq)) * 512 + h * 64 + 4 * g4;
#pragma unroll
    for (int d = 0; d < 4; ++d) { u32x2 w; w.x = cvt_pk_bf16(o[d][0] * inv, o[d][1] * inv); w.y = cvt_pk_bf16(o[d][2] * inv, o[d][3] * inv); *(u32x2*)(op + 16 * d) = w; }
}

__device__ void phase4(const Params& P, unsigned char* lds) {
    const int tid = threadIdx.x, G = gridDim.x, lane = tid & 63, wave = tid >> 6;
    const LAS unsigned char* ldsl = (const LAS unsigned char*)lds;
    float* rpbl = (float*)(lds + ATT_LB);
    int* ctr = (int*)(lds + ATT_LC);
    if (wave < 2) for (int task = blockIdx.x * 2 + wave; task < 512; task += G * 2) scan_task(P, task, lane);
    const bf16_t* kb = (const bf16_t*)(P.ws + WS_C);
    const bf16_t* vtc = kb + (size_t)MALL * 512 + (size_t)MLAT * 512;
    for (int bt = blockIdx.x; bt < 256; bt += G) {
        const int xcd = bt & 7, j = bt >> 3, pair = xcd * 8 + (j >> 2), quarter = j & 3, b = pair >> 3, h = pair & 7;
        __syncthreads();
        for (int idx = tid; idx < 15 * 31; idx += 512) rpbl[idx] = P.rpb[h * 465 + idx] * LOG2E;
        if (tid == 0) *ctr = 0;
#pragma unroll
        for (int i = 0; i < 4; ++i) { const int e = tid + 512 * i, key = e >> 3, ch = e & 7;
            const u32x4 kvv = *(const u32x4*)(kb + ((size_t)MLAT + b * 256 + key) * 512 + h * 64 + ch * 8);
            *(u32x4*)(lds + ATT_LK + key * 144 + ch * 16) = kvv;
            const u32x4 vvv = *(const u32x4*)(vtc + (size_t)(b * 8 + h) * 32 * 512 + (size_t)e * 8);
            *(u32x4*)(lds + ATT_LV + e * 16) = vvv; }
        __syncthreads();
        for (;;) {
            int t = 0; if (lane == 0) t = atomicAdd(ctr, 1);
            t = __shfl(t, 0);
            if (t >= 64) break;
            attn_task(P, b, h, quarter * 16 + (t >> 2), t & 3, lane, rpbl, ldsl);
        }
    }
}

__device__ void phase_final(const Params& P) {
    const int tid = threadIdx.x, G = gridDim.x, lane = tid & 63, wave = tid >> 6;
    const float* ss = (const float*)(P.ws + WS_SSP2);
    const bf16_t* hb = (const bf16_t*)(P.ws + WS_F);
    for (int row0 = blockIdx.x * 8 + wave; row0 < MLAT; row0 += G * 16) {
        const int rows[2] = {row0, row0 + G * 8};
        u32x2 hq[2][4]; f32x4 sp[2];
#pragma unroll
        for (int q = 0; q < 2; ++q) { const int row = rows[q] < MLAT ? rows[q] : row0;
            sp[q] = *(const f32x4*)(ss + (size_t)row * 16 + 4 * (lane & 3));
#pragma unroll
            for (int i = 0; i < 4; ++i) hq[q][i] = __builtin_nontemporal_load((const u32x2*)(hb + (size_t)row * 1024 + 4 * lane + 256 * i)); }
#pragma unroll
        for (int q = 0; q < 2; ++q) { const int row = rows[q]; if (row >= MLAT) continue;
            float t = (sp[q][0] + sp[q][1]) + (sp[q][2] + sp[q][3]); t += __shfl_xor(t, 1); t += __shfl_xor(t, 2);
            const float rstd = 1.0f / sqrtf(t * (1.0f / 1024.0f) + NORM_EPS);
#pragma unroll
            for (int i = 0; i < 4; ++i) { const int c = 4 * lane + 256 * i;
                const f32x4 v = (f32x4){bflo(hq[q][i].x), bfhi(hq[q][i].x), bflo(hq[q][i].y), bfhi(hq[q][i].y)}, gv = *(const f32x4*)(P.final_g + c);
                __builtin_nontemporal_store(v * rstd * gv, (f32x4*)(P.out + (size_t)row * 1024 + c)); } }
    }
}

#define XB_TMO      128
#define XB_XCNT(j)  (256  + 64 * (j))
#define XB_XSUB(j)  (1280 + 64 * (j))
#define XB_XGEN(j)  (2304 + 64 * (j))
#define XB_TOP      3328
#define XB_TOPGEN   3392
#define XCD_BAR_WORDS 3456
#define XB_SPIN_CAP (1u << 18)

__device__ __forceinline__ unsigned xb_ld(unsigned* p)              { return __hip_atomic_load(p, __ATOMIC_RELAXED, __HIP_MEMORY_SCOPE_AGENT); }
__device__ __forceinline__ unsigned xb_add(unsigned* p, unsigned v) { return __hip_atomic_fetch_add(p, v, __ATOMIC_RELAXED, __HIP_MEMORY_SCOPE_AGENT); }
__device__ __forceinline__ unsigned xb_xcc_id() { return (unsigned)__builtin_amdgcn_s_getreg((3 << 11) | 20) & 0xFu; }
#define XB_SPIN(cond, bar) do { unsigned _sp = 0; while (cond) { __builtin_amdgcn_s_sleep(1); \
    if ((++_sp & 255u) == 0u) { if (xb_ld(&(bar)[XB_TMO])) break; if (_sp > XB_SPIN_CAP) { atomicAdd(&(bar)[XB_TMO], 1u); break; } } } } while (0)

struct XcdBarrier {
    unsigned* bar; unsigned x;
    volatile LAS unsigned* st;
};

__device__ __forceinline__ XcdBarrier xcd_barrier_post(unsigned* bar, volatile LAS unsigned* st) {
    XcdBarrier b; b.bar = bar; b.x = xb_xcc_id(); b.st = st;
    if (threadIdx.x == 0) (void)xb_add(&bar[XB_XCNT(b.x)], 1u);
    return b;
}
__device__ __forceinline__ void xcd_barrier_complete(unsigned* bar, unsigned x, unsigned& nloc, unsigned& nx) {
    const unsigned G = gridDim.x * gridDim.y * gridDim.z;
    unsigned sum, cnt, mine, sp = 0u;
    for (;;) {
        sum = 0u; cnt = 0u; mine = 0u;
#pragma unroll
        for (unsigned j = 0; j < 16; ++j) { const unsigned c = xb_ld(&bar[XB_XCNT(j)]); sum += c; cnt += (c > 0u) ? 1u : 0u; mine = (j == x) ? c : mine; }
        if (sum == G) break;
        __builtin_amdgcn_s_sleep(1);
        if ((++sp & 255u) == 0u) { if (xb_ld(&bar[XB_TMO])) break; if (sp > XB_SPIN_CAP) { atomicAdd(&bar[XB_TMO], 1u); break; } }
    }
    nloc = mine > 0u ? mine : 1u; nx = cnt > 0u ? cnt : 1u;
}

__device__ __forceinline__ void xcd_barrier(const XcdBarrier& b) {
    asm volatile("s_waitcnt vmcnt(0)" ::: "memory");
    __syncthreads();
    if (threadIdx.x == 0) {
        unsigned* bar = b.bar;
        __builtin_amdgcn_s_waitcnt(0);
        unsigned nloc = b.st[0], nx = b.st[1];
        if (nloc == 0u) { xcd_barrier_complete(bar, b.x, nloc, nx); b.st[0] = nloc; b.st[1] = nx; }
        const unsigned old = xb_add(&bar[XB_XSUB(b.x)], 1u);
        const unsigned gen = old / nloc;
        if (old + 1u == (gen + 1u) * nloc) {
            __builtin_amdgcn_fence(__ATOMIC_RELEASE, "agent");
            asm volatile("s_waitcnt vmcnt(0)" ::: "memory");
            const unsigned og = xb_add(&bar[XB_TOP], 1u);
            const unsigned tg = og / nx;
            if (og + 1u == (tg + 1u) * nx) xb_add(&bar[XB_TOPGEN], 1u);
            else XB_SPIN(xb_ld(&bar[XB_TOPGEN]) == tg, bar);
            __builtin_amdgcn_fence(__ATOMIC_ACQUIRE, "agent");
            xb_add(&bar[XB_XGEN(b.x)], 1u);
            asm volatile("s_waitcnt vmcnt(0)" ::: "memory");
        } else {
            XB_SPIN(xb_ld(&bar[XB_XGEN(b.x)]) == gen, bar);
            __builtin_amdgcn_fence(__ATOMIC_ACQUIRE, "agent");
            asm volatile("s_waitcnt vmcnt(0)" ::: "memory");
        }
    }
    __syncthreads();
}

constexpr int LDS_BYTES = pg8::STAGE_BYTES + 16;
constexpr int NPHASE = 12;

__global__ void __launch_bounds__(512, 2) fwd_kernel(Params P) {
    extern __shared__ __attribute__((aligned(16))) unsigned char lds[];
    LAS unsigned char* ldsl = (LAS unsigned char*)lds;
    const int G = gridDim.x, cidx = blockIdx.x;
    const int lo = P.ph_lo, hi = P.ph_hi;
#define IN(k) (lo <= (k) && (k) < hi)
    unsigned* barw = (unsigned*)(P.ws + WS_BAR);
    (void)barw;
    volatile LAS unsigned* xst = (volatile LAS unsigned*)(ldsl + pg8::STAGE_BYTES);
    if (threadIdx.x < 4) xst[threadIdx.x] = 0u;
    __syncthreads();
    const XcdBarrier xbar = xcd_barrier_post((unsigned*)(P.ws + WS_BAR + 4096), xst);
#define SEAM(k) do { if (IN(k) && IN((k) + 1)) { if ((k) == 0) cg::this_grid().sync(); else { xcd_barrier(xbar); } } } while (0)
    bf16_t* ws16 = (bf16_t*)P.ws;
    const float* mod = (const float*)(P.ws + WS_MOD);
    if (IN(0)) { phase0(P, lds); } SEAM(0);
    if (IN(1)) {
        const bool split = G > 96, gemm_wg = !split || cidx >= G - 48;
        if (!split || !gemm_wg) phase1(P, lds);
        if (gemm_wg) {
            if (!split) __syncthreads();
            pg8::Gemm g{(const bf16_t*)(P.ws + WS_A), (const bf16_t*)(P.ws + WS_WIN), DM, DM, DM};
            pg8::CtxOrder S{split ? 48 : G, split ? cidx - (G - 48) : cidx};
            bf16_t* kb = (bf16_t*)(P.ws + WS_C);
            EpiInProj E{(bf16_t*)(P.ws + WS_B), kb, kb + (size_t)MALL * 512, kb + (size_t)MALL * 512 + (size_t)MLAT * 512, (bf16_t*)(P.ws + WS_D), (bf16_t*)(P.ws + WS_F), (const f32x2*)(P.ws + WS_ROPE)};
            pg8::gemm_phase(ldsl, g, S, E);
        }
    } SEAM(1);
    if (IN(2)) {
        pg8::Gemm g{(const bf16_t*)(P.ws + WS_A), (const bf16_t*)(P.ws + WS_WIN), DM, DM, DM};
        pg8::StaticOrder S; S.init(MLAT, INC, G, cidx);
        bf16_t* kb = (bf16_t*)(P.ws + WS_C);
        EpiInProj E{(bf16_t*)(P.ws + WS_B), kb, kb + (size_t)MALL * 512, kb + (size_t)MALL * 512 + (size_t)MLAT * 512, (bf16_t*)(P.ws + WS_D), (bf16_t*)(P.ws + WS_F), (const f32x2*)(P.ws + WS_ROPE)};
        pg8::gemm_phase<EpiInProj, pg8::StaticOrder, true, true>(ldsl, g, S, E);
    } SEAM(2);
    if (IN(3)) {
        pg8::Gemm g{(const bf16_t*)(P.ws + WS_D), (const bf16_t*)(P.ws + WS_S5W1), 512, 256, 256};
        pg8::S5Order<9> S; S.init(G, cidx);
        EpiE E{(float*)(P.ws + WS_E)};
        pg8::gemm_phase(ldsl, g, S, E);
    } SEAM(3);
    if (IN(4)) { phase4(P, lds); } SEAM(4);
    if (IN(5)) {
        { pg8::Gemm g{(const bf16_t*)(P.ws + WS_D), (const bf16_t*)(P.ws + WS_S5M2), 512, 512, 512};
          pg8::S5Order<8> S; S.init(G, cidx);
          EpiY E{(const bf16_t*)(P.ws + WS_D), P.ssm_d, (bf16_t*)(P.ws + WS_A) + (size_t)MLAT * 512};
          pg8::gemm_phase(ldsl, g, S, E); }
        { pg8::Gemm g{(const bf16_t*)(P.ws + WS_A), (const bf16_t*)(P.ws + WS_WBA), AW, AW, AW};
          pg8::StaticOrder S; S.init(MLAT, DM, G, cidx);
          EpiBranch<0> E{(const bf16_t*)(P.ws + WS_F), (bf16_t*)(P.ws + WS_C)};
          pg8::gemm_phase<EpiBranch<0>, pg8::StaticOrder, true, true>(ldsl, g, S, E); }
    } SEAM(5);
    if (IN(6)) {
        pg8::Gemm g{(const bf16_t*)(P.ws + WS_A) + (size_t)MLAT * 512, (const bf16_t*)(P.ws + WS_WGLU), SW, SW, SW};
        pg8::StaticOrder S; S.init(MLAT, 2 * SW, G, cidx);
        EpiGLU E{(bf16_t*)(P.ws + WS_B), SW};
        pg8::gemm_phase<EpiGLU, pg8::StaticOrder, true, true>(ldsl, g, S, E);
    } SEAM(6);
    if (IN(7)) {
        pg8::Gemm g{(const bf16_t*)(P.ws + WS_B), (const bf16_t*)(P.ws + WS_WBS), SW, SW, SW};
        pg8::StaticOrder S; S.init(MLAT, DM, G, cidx);
        EpiBranch<1> E{(const bf16_t*)(P.ws + WS_F) + 1024, (bf16_t*)(P.ws + WS_C)};
        pg8::gemm_phase<EpiBranch<1>, pg8::StaticOrder, true, true>(ldsl, g, S, E);
    } SEAM(7);
    if (IN(8)) {
        pg8::Gemm g{(const bf16_t*)(P.ws + WS_C), (const bf16_t*)(P.ws + WS_WOUT), DM, DM, DM};
        pg8::StaticOrder S; S.init(MLAT, DM, G, cidx);
        EpiWout E{P.x, mod, P.ffn_g, (bf16_t*)(P.ws + WS_F), (bf16_t*)(P.ws + WS_E), (float*)(P.ws + WS_SSP1)};
        pg8::gemm_phase<EpiWout, pg8::StaticOrder, true, true>(ldsl, g, S, E);
    } SEAM(8);
    if (IN(9)) {
        pg8::Gemm g{(const bf16_t*)(P.ws + WS_E), (const bf16_t*)(P.ws + WS_WFI), DM, DM, DM};
        pg8::StaticOrder S; S.init(MLAT, 2 * FH, G, cidx);
        EpiFFNIn E{(const float*)(P.ws + WS_SSP1), (const float*)(P.ws + WS_BIAS2), (bf16_t*)(P.ws + WS_HID)};
        pg8::gemm_phase<EpiFFNIn, pg8::StaticOrder, true, true>(ldsl, g, S, E);
    } SEAM(9);
    if (IN(10)) {
        pg8::Gemm g{(const bf16_t*)(P.ws + WS_HID), (const bf16_t*)(P.ws + WS_WFO), FH, FH, FH};
        pg8::StaticOrder S; S.init(MLAT, DM, G, cidx);
        EpiFFNOut E{mod, (bf16_t*)(P.ws + WS_F), (float*)(P.ws + WS_SSP2)};
        pg8::gemm_phase<EpiFFNOut, pg8::StaticOrder, true, true>(ldsl, g, S, E);
    } SEAM(10);
    if (IN(11)) { phase_final(P); }
    (void)ws16;
#undef IN
#undef SEAM
}

extern "C" void kernel_launch(void* const* d_in, const int* in_sizes, int n_in, void* d_out, int out_size, void* d_ws, size_t ws_size, hipStream_t stream) {
    static int grid = 0;
    if (grid == 0) {
        int dev = 0, cus = 0, per_cu = 0;
        (void)hipGetDevice(&dev);
        (void)hipDeviceGetAttribute(&cus, hipDeviceAttributeMultiprocessorCount, dev);
        (void)hipFuncSetAttribute((const void*)fwd_kernel, hipFuncAttributeMaxDynamicSharedMemorySize, LDS_BYTES);
        (void)hipOccupancyMaxActiveBlocksPerMultiprocessor(&per_cu, (const void*)fwd_kernel, 512, LDS_BYTES);
        if (per_cu < 1) { fprintf(stderr, "kernel_launch: occupancy query says %d blocks per CU\n", per_cu); per_cu = 1; }
        grid = cus;
        if (ws_size < WS_END) fprintf(stderr, "kernel_launch: workspace too small: %zu < %zu\n", ws_size, (size_t)WS_END);
    }
    Params p{};
    const float** pp = (const float**)&p;
    for (int i = 0; i < 25; ++i) pp[i] = (const float*)d_in[i];
    p.out = (float*)d_out; p.ws = (unsigned char*)d_ws;
#if ONE_LAUNCH
    (void)hipMemsetAsync((unsigned char*)d_ws + WS_BAR, 0, 4096 + XCD_BAR_WORDS * 4, stream);
    p.ph_lo = 0; p.ph_hi = NPHASE;
    void* args[] = {&p};
    hipError_t e = hipLaunchCooperativeKernel((const void*)fwd_kernel, dim3(grid), dim3(512), args, LDS_BYTES, stream);
    if (e != hipSuccess) fprintf(stderr, "cooperative launch failed: %s (grid %d)\n", hipGetErrorString(e), grid);
#else
    for (int ph = 0; ph < NPHASE; ++ph) {
        p.ph_lo = ph; p.ph_hi = ph + 1;
        hipLaunchKernelGGL(fwd_kernel, dim3(grid), dim3(512), LDS_BYTES, stream, p);
    }
#endif
}
```

```cpp
#include <hip/hip_runtime.h>
#include <hip/hip_cooperative_groups.h>
#include <cstdio>
namespace cg = cooperative_groups;

#ifndef ONE_LAUNCH
#define ONE_LAUNCH 1
#endif

#define LAS __attribute__((address_space(3)))
typedef unsigned short bf16_t;
typedef short bf16x8 __attribute__((ext_vector_type(8)));
typedef float f32x4 __attribute__((ext_vector_type(4)));
typedef float f32x2 __attribute__((ext_vector_type(2)));
typedef unsigned u32x4 __attribute__((ext_vector_type(4)));
typedef unsigned u32x2 __attribute__((ext_vector_type(2)));

constexpr int NB = 8, SEQL = 4096, DM = 1024, LCTX = 256, NH = 8, HD = 64, AW = 512, SW = 512, NG = 32, NP = 64, HG = 16, FH = 2816, INC = 4096;
constexpr int MLAT = NB * SEQL;
constexpr int MCTX = NB * LCTX;
constexpr int MALL = MLAT + MCTX;
constexpr int XH_ROWS = 2304;
constexpr float NORM_EPS = 1e-6f;
constexpr float LOG2E = 1.4426950408889634f;

constexpr size_t MiB = (size_t)1 << 20;
constexpr size_t WS_MOD = 0;
constexpr size_t WS_ROPE = 256 * 1024;
constexpr size_t WS_LBT = WS_ROPE + 16 * 1024;
constexpr size_t WS_SS1 = 512 * 1024;
constexpr size_t WS_SS2 = 640 * 1024;
constexpr size_t WS_BIAS2 = 768 * 1024;
constexpr size_t WS_BAR = 1024 * 1024;
constexpr size_t WS_WIN = 2 * MiB;
constexpr size_t WS_WGLU = 10 * MiB;
constexpr size_t WS_WBA = 11 * MiB;
constexpr size_t WS_WBS = 12 * MiB;
constexpr size_t WS_WOUT = 13 * MiB;
constexpr size_t WS_WFI = 15 * MiB;
constexpr size_t WS_WFO = 26 * MiB;
constexpr size_t WS_S5W1 = 32 * MiB;
constexpr size_t WS_S5M2 = 36 * MiB;
constexpr size_t WS_A = 44 * MiB;
constexpr size_t WS_B = 112 * MiB;
constexpr size_t WS_C = 144 * MiB;
constexpr size_t WS_D = 212 * MiB;
constexpr size_t WS_F = 284 * MiB;
constexpr size_t WS_E = 412 * MiB;
constexpr size_t WS_SSP1 = 484 * MiB;
constexpr size_t WS_SSP2 = 486 * MiB;
constexpr size_t WS_END = 488 * MiB;
constexpr size_t WS_HID = WS_A;

typedef __bf16 bf16x2_t __attribute__((ext_vector_type(2)));
__device__ __forceinline__ unsigned cvt_pk_bf16(float lo, float hi) { f32x2 f = {lo, hi}; bf16x2_t v = __builtin_convertvector(f, bf16x2_t); return __builtin_bit_cast(unsigned, v); }
__device__ __forceinline__ bf16_t f2bf(float v) { return (bf16_t)(cvt_pk_bf16(v, 0.f) & 0xffffu); }
__device__ __forceinline__ float bf2f(unsigned short b) { return __uint_as_float(((unsigned)b) << 16); }
__device__ __forceinline__ float bflo(unsigned w) { return __uint_as_float(w << 16); }
__device__ __forceinline__ float bfhi(unsigned w) { return __uint_as_float(w & 0xffff0000u); }
__device__ __forceinline__ float xmax32(float x) { auto r = __builtin_amdgcn_permlane32_swap(__float_as_uint(x), __float_as_uint(x), false, false); return fmaxf(__uint_as_float(r[0]), __uint_as_float(r[1])); }
__device__ __forceinline__ float xmax16(float x) { auto r = __builtin_amdgcn_permlane16_swap(__float_as_uint(x), __float_as_uint(x), false, false); return fmaxf(__uint_as_float(r[0]), __uint_as_float(r[1])); }
__device__ __forceinline__ float xsum32(float x) { auto r = __builtin_amdgcn_permlane32_swap(__float_as_uint(x), __float_as_uint(x), false, false); return __uint_as_float(r[0]) + __uint_as_float(r[1]); }
__device__ __forceinline__ float xsum16(float x) { auto r = __builtin_amdgcn_permlane16_swap(__float_as_uint(x), __float_as_uint(x), false, false); return __uint_as_float(r[0]) + __uint_as_float(r[1]); }
__device__ __forceinline__ float fast_sigmoid(float x) { return __builtin_amdgcn_rcpf(1.0f + __builtin_amdgcn_exp2f(-x * LOG2E)); }

namespace pg8 {
constexpr int BM = 256, BK = 64, HALF = 128, HTB = HALF * BK * 2, STAGE_BYTES = 8 * HTB, NXCD = 8, WGM = 8;
__host__ __device__ __forceinline__ int lds_byte(int r, int c) { const int st = (r >> 4) * 2 + (c >> 5), rr = r & 15, cc = c & 31, ob = rr * 64 + cc * 2; return st * 1024 + (ob ^ (((ob >> 9) & 1) << 5)); }
__host__ __device__ __forceinline__ void stage_rc(int b, int& R, int& C) { const int st = b / 1024, sb = b % 1024, swz = sb ^ (((sb >> 9) & 1) << 5); R = (st >> 1) * 16 + swz / 64; C = (st & 1) * 32 + (swz % 64) / 2; }
__host__ __device__ __forceinline__ int perm32(int rho) { const int n = rho >> 4, i = rho & 15; return 8 * (i >> 2) + 4 * n + (i & 3); }

struct Unit { int pm, pn; };
struct Gemm { const bf16_t* A; const bf16_t* Bt; int lda, ldb, K; };

struct StaticOrder {
    int nM, nN, nwg, G, c;
    __device__ void init(int M, int N, int G_, int c_) { nM = M / BM; nN = N / BM; nwg = nM * nN; G = G_; c = c_; }
    __device__ bool map(long L, Unit& u) const {
        if (L >= nwg) return false;
        int wgid = (int)L; { const int q = nwg / NXCD, r = nwg % NXCD, xcd = wgid % NXCD, off = wgid / NXCD; wgid = (xcd < r ? xcd * (q + 1) : r * (q + 1) + (xcd - r) * q) + off; }
        const int nig = WGM * nN, gid = wgid / nig, fm = gid * WGM, gsz = (nM - fm) < WGM ? (nM - fm) : WGM;
        u.pm = fm + ((wgid % nig) % gsz); u.pn = (wgid % nig) / gsz; return true;
    }
    __device__ bool next(int i, Unit& u) const { return map((long)i * G + c, u); }
};
struct CtxOrder {
    int Gc, c;
    __device__ bool next(int i, Unit& u) const { const int j = i * Gc + c; if (j >= 48) return false; u.pm = 128 + j / 6; u.pn = 2 + j % 6; return true; }
};
template <int NT> struct S5Order {
    int G, c;
    __device__ void init(int G_, int c_) { G = G_; c = c_; }
    __device__ bool next(int i, Unit& u) const {
        const long L = (long)i * G + c; if (L >= 32 * NT) return false;
        const int g = (int)L / NT, t = (int)L % NT; u.pm = g * 9 + t; u.pn = g; return true;
    }
};

template <class Epi, class Sched, bool ALIGN_EPI = false, bool SP2 = false>
__device__ __forceinline__ void gemm_phase(LAS unsigned char* lds, const Gemm g, const Sched& S, const Epi& E) {
    const int tid = threadIdx.x, wid = __builtin_amdgcn_readfirstlane(tid >> 6), lane = tid & 63, wr = wid >> 2, wc = wid & 3, fr = lane & 15, fq = lane >> 4;
    const int K = g.K, nt = K / BK;
    unsigned voffA[2], voffB[2];
#pragma unroll
    for (int i = 0; i < 2; ++i) { int R, C; stage_rc(tid * 16 + i * 8192, R, C); const int Rb = Epi::PERM ? ((R & ~31) + perm32(R & 31)) : R;
        voffA[i] = (unsigned)(R * g.lda + C) * 2u; voffB[i] = (unsigned)(Rb * g.ldb + C) * 2u; }
    const size_t kstep = (size_t)(BK * 2);
    const size_t hstepA = (size_t)HALF * g.lda * 2, hstepB = (size_t)HALF * g.ldb * 2;
    const size_t tstepA = 2 * hstepA, tstepB = 2 * hstepB;
    const unsigned ldsw = (unsigned)wid * 1024u;
    const int aoff = lds_byte(wr * 64 + fr, fq * 8), boff = lds_byte(wc * 32 + fr, fq * 8);
#define PG8_SA(b, h) (((b) * 2 + (h)) * HTB)
#define PG8_SB(b, h) ((4 + (b) * 2 + (h)) * HTB)
#define PG8_STAGE(bufoff, gbase, voff) do { _Pragma("unroll") for (int _i = 0; _i < 2; ++_i) \
        __builtin_amdgcn_global_load_lds((const unsigned*)((const char*)(gbase) + (voff)[_i]), (LAS unsigned*)(lds + (bufoff) + ldsw + _i * 8192), 16, 0, 0); } while (0)
#define PG8_LDA(dst, b, h) do { _Pragma("unroll") for (int m = 0; m < 4; ++m) _Pragma("unroll") for (int k = 0; k < 2; ++k) dst[m][k] = *(const LAS bf16x8*)(lds + PG8_SA(b, h) + aoff + m * 2048 + k * 1024); } while (0)
#define PG8_LDB(dst, b, h) do { _Pragma("unroll") for (int n = 0; n < 2; ++n) _Pragma("unroll") for (int k = 0; k < 2; ++k) dst[n][k] = *(const LAS bf16x8*)(lds + PG8_SB(b, h) + boff + n * 2048 + k * 1024); } while (0)
#define PG8_MMA(ai, bj, At, Bt) do { __builtin_amdgcn_s_setprio(1); _Pragma("unroll") for (int m = 0; m < 4; ++m) _Pragma("unroll") for (int n = 0; n < 2; ++n) _Pragma("unroll") for (int k = 0; k < 2; ++k) \
        acc[ai][bj][m][n] = __builtin_amdgcn_mfma_f32_16x16x32_bf16(Bt[n][k], At[m][k], acc[ai][bj][m][n], 0, 0, 0); __builtin_amdgcn_s_setprio(0); } while (0)
#define PG8_WAIT_V(n) asm volatile("s_waitcnt vmcnt(" #n ")" ::: "memory")
#define PG8_WAIT_L(n) asm volatile("s_waitcnt lgkmcnt(" #n ")" ::: "memory")
#define PG8_BAR __builtin_amdgcn_s_barrier()
#define PG8_SCHED __builtin_amdgcn_sched_barrier(0)
    Unit cur, nxt; int ui = 0;
    if (!S.next(0, cur)) return;
    f32x4 acc[2][2][4][2];
#pragma unroll
    for (int a = 0; a < 2; ++a)
#pragma unroll
        for (int b = 0; b < 2; ++b)
#pragma unroll
            for (int m = 0; m < 4; ++m)
#pragma unroll
                for (int n = 0; n < 2; ++n) acc[a][b][m][n] = (f32x4){0.f, 0.f, 0.f, 0.f};
    bf16x8 At[4][2], B0[2][2], B1[2][2];
    const char* cA = (const char*)g.A + (size_t)cur.pm * tstepA; const char* cB = (const char*)g.Bt + (size_t)cur.pn * tstepB;
    if constexpr (SP2) {
        PG8_STAGE(PG8_SB(0, 0), cB, voffB); PG8_STAGE(PG8_SB(0, 1), cB + hstepB, voffB); PG8_STAGE(PG8_SA(0, 0), cA, voffA); PG8_STAGE(PG8_SA(0, 1), cA + hstepA, voffA);
        if (wr == 1) PG8_BAR;
        PG8_WAIT_V(2); PG8_BAR;
        PG8_STAGE(PG8_SB(1, 0), cB + kstep, voffB); PG8_STAGE(PG8_SA(1, 0), cA + kstep, voffA); PG8_STAGE(PG8_SB(1, 1), cB + hstepB + kstep, voffB);
        PG8_WAIT_V(6); PG8_BAR;
    } else {
        PG8_STAGE(PG8_SB(0, 0), cB, voffB); PG8_STAGE(PG8_SA(0, 0), cA, voffA); PG8_STAGE(PG8_SB(0, 1), cB + hstepB, voffB); PG8_STAGE(PG8_SA(0, 1), cA + hstepA, voffA);
        if (wr == 1) PG8_BAR;
        PG8_WAIT_V(4); PG8_BAR;
        PG8_STAGE(PG8_SB(1, 0), cB + kstep, voffB); PG8_STAGE(PG8_SA(1, 0), cA + kstep, voffA); PG8_STAGE(PG8_SB(1, 1), cB + hstepB + kstep, voffB);
        PG8_WAIT_V(6); PG8_BAR;
    }
    for (;;) {
        const bool has_next = S.next(ui + 1, nxt);
        const char* nA = has_next ? (const char*)g.A + (size_t)nxt.pm * tstepA : cA; const char* nB = has_next ? (const char*)g.Bt + (size_t)nxt.pn * tstepB : cB;
        for (int t = 0; t < nt; t += 2) {
            const bool last = (t == nt - 2);
            const char* a1 = cA + (size_t)(t + 1) * kstep;
            const char* a2 = last ? nA : cA + (size_t)(t + 2) * kstep; const char* b2 = last ? nB : cB + (size_t)(t + 2) * kstep;
            const char* a3 = a2 + kstep; const char* b3 = b2 + kstep;
            if constexpr (SP2) {
            PG8_LDB(B0, 0, 0); PG8_LDB(B1, 0, 1); PG8_SCHED; PG8_LDA(At, 0, 0); PG8_STAGE(PG8_SA(1, 1), a1 + hstepA, voffA);
            PG8_WAIT_V(8); PG8_WAIT_L(0); PG8_BAR; PG8_MMA(0, 0, At, B0); PG8_MMA(0, 1, At, B1); PG8_BAR; PG8_SCHED;
            PG8_LDA(At, 0, 1); PG8_STAGE(PG8_SB(0, 0), b2, voffB); PG8_STAGE(PG8_SB(0, 1), b2 + hstepB, voffB); PG8_STAGE(PG8_SA(0, 0), a2, voffA);
            PG8_WAIT_V(8); PG8_WAIT_L(0); PG8_BAR; PG8_MMA(1, 0, At, B0); PG8_MMA(1, 1, At, B1); PG8_BAR; PG8_SCHED;
            PG8_LDB(B0, 1, 0); PG8_LDB(B1, 1, 1); PG8_SCHED; PG8_LDA(At, 1, 0); PG8_STAGE(PG8_SA(0, 1), a2 + hstepA, voffA);
            PG8_WAIT_V(8); PG8_WAIT_L(0); PG8_BAR; PG8_MMA(0, 0, At, B0); PG8_MMA(0, 1, At, B1); PG8_BAR; PG8_SCHED;
            PG8_LDA(At, 1, 1); PG8_STAGE(PG8_SB(1, 0), b3, voffB); PG8_STAGE(PG8_SB(1, 1), b3 + hstepB, voffB); PG8_STAGE(PG8_SA(1, 0), a3, voffA);
            PG8_WAIT_V(8); PG8_WAIT_L(0); PG8_BAR; PG8_MMA(1, 0, At, B0); PG8_MMA(1, 1, At, B1); PG8_BAR; PG8_SCHED;
            } else {
            PG8_LDB(B0, 0, 0); PG8_SCHED; PG8_LDA(At, 0, 0); PG8_STAGE(PG8_SA(1, 1), a1 + hstepA, voffA);
            PG8_WAIT_L(8); PG8_BAR; PG8_WAIT_L(0); PG8_MMA(0, 0, At, B0); PG8_BAR; PG8_SCHED;
            PG8_LDB(B1, 0, 1); PG8_STAGE(PG8_SB(0, 0), b2, voffB);
            PG8_BAR; PG8_WAIT_L(0); PG8_MMA(0, 1, At, B1); PG8_BAR;
            PG8_LDA(At, 0, 1); PG8_STAGE(PG8_SA(0, 0), a2, voffA);
            PG8_BAR; PG8_WAIT_L(0); PG8_MMA(1, 0, At, B0); PG8_BAR; PG8_SCHED;
            PG8_STAGE(PG8_SB(0, 1), b2 + hstepB, voffB);
            PG8_WAIT_V(6); PG8_BAR; PG8_MMA(1, 1, At, B1); PG8_BAR;
            PG8_LDB(B0, 1, 0); PG8_SCHED; PG8_LDA(At, 1, 0); PG8_STAGE(PG8_SA(0, 1), a2 + hstepA, voffA);
            PG8_WAIT_L(8); PG8_BAR; PG8_WAIT_L(0); PG8_MMA(0, 0, At, B0); PG8_BAR; PG8_SCHED;
            PG8_LDB(B1, 1, 1); PG8_STAGE(PG8_SB(1, 0), b3, voffB);
            PG8_BAR; PG8_WAIT_L(0); PG8_MMA(0, 1, At, B1); PG8_BAR;
            PG8_LDA(At, 1, 1); PG8_STAGE(PG8_SA(1, 0), a3, voffA);
            PG8_BAR; PG8_WAIT_L(0); PG8_MMA(1, 0, At, B0); PG8_BAR; PG8_SCHED;
            PG8_STAGE(PG8_SB(1, 1), b3 + hstepB, voffB);
            PG8_WAIT_V(6); PG8_BAR; PG8_MMA(1, 1, At, B1); PG8_BAR;
                    }
        }
        if constexpr (ALIGN_EPI) { if (wr == 0) PG8_BAR; }
        E(acc, cur, wr, wc, fr, fq);
        if (!has_next) break;
#pragma unroll
        for (int a = 0; a < 2; ++a)
#pragma unroll
            for (int b = 0; b < 2; ++b)
#pragma unroll
                for (int m = 0; m < 4; ++m)
#pragma unroll
                    for (int n = 0; n < 2; ++n) acc[a][b][m][n] = (f32x4){0.f, 0.f, 0.f, 0.f};
        cur = nxt; cA = nA; cB = nB; ++ui;
        if constexpr (ALIGN_EPI) { if (wr == 1) PG8_BAR; }
    }
    PG8_WAIT_V(0);
    if constexpr (!ALIGN_EPI) { if (wr == 0) PG8_BAR; }
    PG8_BAR;
#undef PG8_SA
#undef PG8_SB
#undef PG8_STAGE
#undef PG8_LDA
#undef PG8_LDB
#undef PG8_MMA
#undef PG8_WAIT_V
#undef PG8_WAIT_L
#undef PG8_BAR
#undef PG8_SCHED
}
}
using pg8::Unit;

#define EPI_ROWS_BEGIN _Pragma("unroll") for (int ai = 0; ai < 2; ++ai) _Pragma("unroll") for (int m = 0; m < 4; ++m) {
#define EPI_ROWS_END }

struct EpiInProj {
    static constexpr bool PERM = true;
    bf16_t *q, *k, *vt, *vtc, *xh, *sig; const f32x2* rope;
    __device__ __forceinline__ void operator()(const f32x4 (&acc)[2][2][4][2], const Unit& u, int wr, int wc, int fr, int fq) const {
        const int pn = u.pn; const bool isctx = u.pm >= 128;
        const int kind = pn < 2 ? 0 : pn < 4 ? 1 : pn < 6 ? 2 : pn < 8 ? 3 : 4;
        EPI_ROWS_BEGIN
            const int r = u.pm * 256 + ai * 128 + wr * 64 + m * 16 + fr;
#pragma unroll
            for (int bj = 0; bj < 2; ++bj) {
                const int c = pn * 256 + bj * 128 + wc * 32 + 8 * fq;
                f32x4 v0 = acc[ai][bj][m][0], v1 = acc[ai][bj][m][1];
                if (kind <= 1) {
                    if (!isctx) {
                        const int t = r & 4095; const int pos = (wc & 1) ? (t & 63) : (t >> 6);
                        const f32x4* cs = (const f32x4*)(rope + pos * 16 + 8 * (fq & 1));
                        const f32x4 cs0 = cs[0], cs1 = cs[1], cs2 = cs[2], cs3 = cs[3];
                        const float sg = (fq >> 1) ? 1.0f : -1.0f;
                        f32x4 p0, p1;
#pragma unroll
                        for (int j = 0; j < 4; ++j) { p0[j] = __shfl_xor(v0[j], 32); p1[j] = __shfl_xor(v1[j], 32); }
                        v0[0] = v0[0] * cs0[0] + sg * p0[0] * cs0[1]; v0[1] = v0[1] * cs0[2] + sg * p0[1] * cs0[3];
                        v0[2] = v0[2] * cs1[0] + sg * p0[2] * cs1[1]; v0[3] = v0[3] * cs1[2] + sg * p0[3] * cs1[3];
                        v1[0] = v1[0] * cs2[0] + sg * p1[0] * cs2[1]; v1[1] = v1[1] * cs2[2] + sg * p1[1] * cs2[3];
                        v1[2] = v1[2] * cs3[0] + sg * p1[2] * cs3[1]; v1[3] = v1[3] * cs3[2] + sg * p1[3] * cs3[3];
                    }
                    u32x4 w; w.x = cvt_pk_bf16(v0[0], v0[1]); w.y = cvt_pk_bf16(v0[2], v0[3]); w.z = cvt_pk_bf16(v1[0], v1[1]); w.w = cvt_pk_bf16(v1[2], v1[3]);
                    bf16_t* dst = (kind == 0) ? (q + (size_t)r * 512 + c) : (k + (size_t)r * 512 + (c - 512));
                    *(u32x4*)dst = w;
                } else if (kind == 2) {
                    const int cv = c - 1024, h = cv >> 6, d0 = cv & 63;
                    bf16_t* dst;
                    if (!isctx) { const int b = r >> 12, t = r & 4095; dst = vt + ((size_t)((b * 8 + h) * 512 + (t >> 3))) * 512 + d0 * 8 + (t & 7); }
                    else { const int rc = r - MLAT, b = rc >> 8, mm = rc & 255; dst = vtc + ((size_t)((b * 8 + h) * 32 + (mm >> 3))) * 512 + d0 * 8 + (mm & 7); }
#pragma unroll
                    for (int j = 0; j < 4; ++j) { dst[8 * j] = f2bf(v0[j]); dst[8 * (4 + j)] = f2bf(v1[j]); }
                } else if (kind == 3) {
                    const int cu = c - 1536, g = cu >> 4, h0 = cu & 15;
                    size_t row; int col;
                    if (!isctx) { const int b = r >> 12, t = r & 4095; row = (size_t)g * XH_ROWS + b * 256 + (t >> 4); col = (t & 15) * 16 + h0; }
                    else { const int rc = r - MLAT, b = rc >> 8, mm = rc & 255; row = (size_t)g * XH_ROWS + 2048 + b * 16 + (mm >> 4); col = (mm & 15) * 16 + h0; }
                    u32x4 w; w.x = cvt_pk_bf16(v0[0], v0[1]); w.y = cvt_pk_bf16(v0[2], v0[3]); w.z = cvt_pk_bf16(v1[0], v1[1]); w.w = cvt_pk_bf16(v1[2], v1[3]);
                    *(u32x4*)(xh + row * 512 + col) = w;
                } else {
                    u32x4 w; w.x = cvt_pk_bf16(fast_sigmoid(v0[0]), fast_sigmoid(v0[1])); w.y = cvt_pk_bf16(fast_sigmoid(v0[2]), fast_sigmoid(v0[3]));
                    w.z = cvt_pk_bf16(fast_sigmoid(v1[0]), fast_sigmoid(v1[1])); w.w = cvt_pk_bf16(fast_sigmoid(v1[2]), fast_sigmoid(v1[3]));
                    *(u32x4*)(sig + (size_t)r * 2048 + (c - 2048)) = w;
                }
            }
        EPI_ROWS_END
    }
};

struct EpiE {
    static constexpr bool PERM = false;
    float* E;
    __device__ __forceinline__ void operator()(const f32x4 (&acc)[2][2][4][2], const Unit& u, int wr, int wc, int fr, int fq) const {
        EPI_ROWS_BEGIN
            const int r = u.pm * 256 + ai * 128 + wr * 64 + m * 16 + fr;
            float* rowp = E + (size_t)r * 256 + wc * 32 + 4 * fq;
#pragma unroll
            for (int bj = 0; bj < 2; ++bj)
#pragma unroll
                for (int n = 0; n < 2; ++n) *(f32x4*)(rowp + bj * 128 + n * 16) = acc[ai][bj][m][n];
        EPI_ROWS_END
    }
};

__device__ __forceinline__ float gelu_tanh(float x) {
    const float z = 1.5957691216057308f * (x + 0.044715f * x * x * x);
    return x * fast_sigmoid(z);
}

struct EpiY {
    static constexpr bool PERM = true;
    const bf16_t* xh; const float* dsk; bf16_t* y;
    __device__ __forceinline__ void operator()(const f32x4 (&acc)[2][2][4][2], const Unit& u, int wr, int wc, int fr, int fq) const {
        const int g = u.pn, it = u.pm - g * 9;
        const int rr0 = wr * 64 + fr, c00 = wc * 32 + 8 * fq, h0 = c00 & 15;
        u32x4 uu[2][4][2];
#pragma unroll
        for (int ai = 0; ai < 2; ++ai)
#pragma unroll
            for (int m = 0; m < 4; ++m)
#pragma unroll
                for (int bj = 0; bj < 2; ++bj) uu[ai][m][bj] = *(const u32x4*)(xh + ((size_t)u.pm * 256 + rr0 + ai * 128 + m * 16) * 512 + c00 + bj * 128);
        const f32x4 d0 = *(const f32x4*)(dsk + g * 16 + h0), d1 = *(const f32x4*)(dsk + g * 16 + h0 + 4);
        EPI_ROWS_BEGIN
            const int rr = rr0 + ai * 128 + m * 16;
            const int idx = it * 256 + rr, b = idx >> 8, cch = idx & 255;
#pragma unroll
            for (int bj = 0; bj < 2; ++bj) {
                const int t = (c00 + bj * 128) >> 4;
                const u32x4 w4 = uu[ai][m][bj];
                const f32x4 v0 = acc[ai][bj][m][0], v1 = acc[ai][bj][m][1];
                float o[8];
                o[0] = v0[0] + d0[0] * bflo(w4.x); o[1] = v0[1] + d0[1] * bfhi(w4.x); o[2] = v0[2] + d0[2] * bflo(w4.y); o[3] = v0[3] + d0[3] * bfhi(w4.y);
                o[4] = v1[0] + d1[0] * bflo(w4.z); o[5] = v1[1] + d1[1] * bfhi(w4.z); o[6] = v1[2] + d1[2] * bflo(w4.w); o[7] = v1[3] + d1[3] * bfhi(w4.w);
#pragma unroll
                for (int j = 0; j < 8; ++j) o[j] = gelu_tanh(o[j]);
                u32x4 w; w.x = cvt_pk_bf16(o[0], o[1]); w.y = cvt_pk_bf16(o[2], o[3]); w.z = cvt_pk_bf16(o[4], o[5]); w.w = cvt_pk_bf16(o[6], o[7]);
                *(u32x4*)(y + ((size_t)(b * 4096 + cch * 16 + t)) * 512 + g * 16 + h0) = w;
            }
        EPI_ROWS_END
    }
};

struct EpiGLU {
    static constexpr bool PERM = true;
    bf16_t* o; int ld;
    __device__ __forceinline__ void operator()(const f32x4 (&acc)[2][2][4][2], const Unit& u, int wr, int wc, int fr, int fq) const {
        EPI_ROWS_BEGIN
            const int r = u.pm * 256 + ai * 128 + wr * 64 + m * 16 + fr;
            const int oc = u.pn * 128 + wc * 32 + 8 * fq;
            const f32x4 a0 = acc[ai][0][m][0], a1 = acc[ai][0][m][1], g0 = acc[ai][1][m][0], g1 = acc[ai][1][m][1];
            u32x4 w; w.x = cvt_pk_bf16(a0[0] * fast_sigmoid(g0[0]), a0[1] * fast_sigmoid(g0[1])); w.y = cvt_pk_bf16(a0[2] * fast_sigmoid(g0[2]), a0[3] * fast_sigmoid(g0[3]));
            w.z = cvt_pk_bf16(a1[0] * fast_sigmoid(g1[0]), a1[1] * fast_sigmoid(g1[1])); w.w = cvt_pk_bf16(a1[2] * fast_sigmoid(g1[2]), a1[3] * fast_sigmoid(g1[3]));
            *(u32x4*)(o + (size_t)r * ld + oc) = w;
        EPI_ROWS_END
    }
};

template <int SECOND> struct EpiBranch {
    static constexpr bool PERM = true;
    const bf16_t* sig; bf16_t* mb;
    __device__ __forceinline__ void operator()(const f32x4 (&acc)[2][2][4][2], const Unit& u, int wr, int wc, int fr, int fq) const {
        const int r0 = u.pm * 256 + wr * 64 + fr, c00 = u.pn * 256 + wc * 32 + 8 * fq;
#pragma unroll
        for (int ai = 0; ai < 2; ++ai) {
            u32x4 sg[4][2], pv[4][2];
#pragma unroll
            for (int m = 0; m < 4; ++m)
#pragma unroll
                for (int bj = 0; bj < 2; ++bj) { const size_t r = (size_t)(r0 + ai * 128 + m * 16);
                    sg[m][bj] = *(const u32x4*)(sig + r * 2048 + c00 + bj * 128);
                    if (SECOND) pv[m][bj] = *(const u32x4*)(mb + r * 1024 + c00 + bj * 128); }
#pragma unroll
            for (int m = 0; m < 4; ++m)
#pragma unroll
                for (int bj = 0; bj < 2; ++bj) {
                    const u32x4 sv = sg[m][bj];
                    const f32x4 v0 = acc[ai][bj][m][0], v1 = acc[ai][bj][m][1];
                    float o[8];
                    o[0] = v0[0] * bflo(sv.x); o[1] = v0[1] * bfhi(sv.x); o[2] = v0[2] * bflo(sv.y); o[3] = v0[3] * bfhi(sv.y);
                    o[4] = v1[0] * bflo(sv.z); o[5] = v1[1] * bfhi(sv.z); o[6] = v1[2] * bflo(sv.w); o[7] = v1[3] * bfhi(sv.w);
                    if (SECOND) { const u32x4 pp = pv[m][bj];
                        o[0] += bflo(pp.x); o[1] += bfhi(pp.x); o[2] += bflo(pp.y); o[3] += bfhi(pp.y); o[4] += bflo(pp.z); o[5] += bfhi(pp.z); o[6] += bflo(pp.w); o[7] += bfhi(pp.w); }
                    u32x4 w; w.x = cvt_pk_bf16(o[0], o[1]); w.y = cvt_pk_bf16(o[2], o[3]); w.z = cvt_pk_bf16(o[4], o[5]); w.w = cvt_pk_bf16(o[6], o[7]);
                    *(u32x4*)(mb + (size_t)(r0 + ai * 128 + m * 16) * 1024 + c00 + bj * 128) = w;
                }
        }
    }
};

struct EpiWout {
    static constexpr bool PERM = true;
    const float* x; const float* mod; const float* gffn; bf16_t* out; bf16_t* ap; float* ss;
    __device__ __forceinline__ void operator()(const f32x4 (&acc)[2][2][4][2], const Unit& u, int wr, int wc, int fr, int fq) const {
        const int b = u.pm >> 4;
        const float* g1 = mod + b * 6144 + 2 * 1024; const float* sc2 = mod + b * 6144 + 4 * 1024;
        const int r0 = u.pm * 256 + wr * 64 + fr, c00 = u.pn * 256 + wc * 32 + 8 * fq;
        f32x4 gv[2][2], gs[2][2];
#pragma unroll
        for (int bj = 0; bj < 2; ++bj)
#pragma unroll
            for (int n = 0; n < 2; ++n) { const int c = c00 + bj * 128 + 4 * n; gv[bj][n] = *(const f32x4*)(g1 + c); gs[bj][n] = *(const f32x4*)(gffn + c) * (*(const f32x4*)(sc2 + c) + 1.0f); }
#pragma unroll
        for (int ai = 0; ai < 2; ++ai)
#pragma unroll
        for (int mh = 0; mh < 2; ++mh) {
            f32x4 xv[2][2][2];
#pragma unroll
            for (int m2 = 0; m2 < 2; ++m2)
#pragma unroll
                for (int bj = 0; bj < 2; ++bj)
#pragma unroll
                    for (int n = 0; n < 2; ++n) xv[m2][bj][n] = *(const f32x4*)(x + (size_t)(r0 + ai * 128 + (mh * 2 + m2) * 16) * 1024 + c00 + bj * 128 + 4 * n);
#pragma unroll
            for (int m2 = 0; m2 < 2; ++m2) { const int m = mh * 2 + m2;
                const size_t r = (size_t)(r0 + ai * 128 + m * 16);
                float sq = 0.f;
#pragma unroll
                for (int bj = 0; bj < 2; ++bj)
#pragma unroll
                    for (int n = 0; n < 2; ++n) {
                        const int c = c00 + bj * 128 + 4 * n;
                        const f32x4 h = xv[m2][bj][n] + gv[bj][n] * acc[ai][bj][m][n];
                        { u32x2 hw; hw.x = cvt_pk_bf16(h[0], h[1]); hw.y = cvt_pk_bf16(h[2], h[3]); *(u32x2*)(out + r * 1024 + c) = hw; }
                        sq += h[0] * h[0] + h[1] * h[1] + h[2] * h[2] + h[3] * h[3];
                        const f32x4 a = h * gs[bj][n];
                        u32x2 w; w.x = cvt_pk_bf16(a[0], a[1]); w.y = cvt_pk_bf16(a[2], a[3]);
                        *(u32x2*)(ap + r * 1024 + c) = w;
                    }
                sq = xsum16(xsum32(sq));
                if (fq == 0) ss[r * 16 + u.pn * 4 + wc] = sq;
            }
        }
    }
};

struct EpiFFNIn {
    static constexpr bool PERM = true;
    const float* ss; const float* bias2; bf16_t* hid;
    __device__ __forceinline__ void operator()(const f32x4 (&acc)[2][2][4][2], const Unit& u, int wr, int wc, int fr, int fq) const {
        const int b = u.pm >> 4;
        const int r0 = u.pm * 256 + wr * 64 + fr, c00 = u.pn * 256 + wc * 32 + 8 * fq, oc = u.pn * 128 + wc * 32 + 8 * fq;
        f32x4 sp[8], ba[2], bb[2];
#pragma unroll
        for (int i = 0; i < 8; ++i) sp[i] = *(const f32x4*)(ss + (size_t)(r0 + (i >> 2) * 128 + (i & 3) * 16) * 16 + 4 * fq);
#pragma unroll
        for (int n = 0; n < 2; ++n) { ba[n] = *(const f32x4*)(bias2 + b * 5632 + c00 + 4 * n); bb[n] = *(const f32x4*)(bias2 + b * 5632 + c00 + 128 + 4 * n); }
        float rstd[8];
#pragma unroll
        for (int i = 0; i < 8; ++i) { float t = (sp[i][0] + sp[i][1]) + (sp[i][2] + sp[i][3]); t = xsum16(xsum32(t)); rstd[i] = 1.0f / sqrtf(t * (1.0f / 1024.0f) + NORM_EPS); }
        EPI_ROWS_BEGIN
            const int r = r0 + ai * 128 + m * 16;
            u32x4 w;
#pragma unroll
            for (int n = 0; n < 2; ++n) {
                const f32x4 va = acc[ai][0][m][n] * rstd[ai * 4 + m] + ba[n], vb = acc[ai][1][m][n] * rstd[ai * 4 + m] + bb[n];
                const unsigned lo = cvt_pk_bf16(va[0] * fast_sigmoid(va[0]) * vb[0], va[1] * fast_sigmoid(va[1]) * vb[1]);
                const unsigned hi = cvt_pk_bf16(va[2] * fast_sigmoid(va[2]) * vb[2], va[3] * fast_sigmoid(va[3]) * vb[3]);
                if (n == 0) { w.x = lo; w.y = hi; } else { w.z = lo; w.w = hi; }
            }
            *(u32x4*)(hid + (size_t)r * FH + oc) = w;
        EPI_ROWS_END
    }
};

struct EpiFFNOut {
    static constexpr bool PERM = true;
    const float* mod; bf16_t* out; float* ss;
    __device__ __forceinline__ void operator()(const f32x4 (&acc)[2][2][4][2], const Unit& u, int wr, int wc, int fr, int fq) const {
        const int b = u.pm >> 4;
        const float* g2 = mod + b * 6144 + 5 * 1024;
        const int r0 = u.pm * 256 + wr * 64 + fr, c00 = u.pn * 256 + wc * 32 + 8 * fq;
        f32x4 gv[2][2];
#pragma unroll
        for (int bj = 0; bj < 2; ++bj)
#pragma unroll
            for (int n = 0; n < 2; ++n) gv[bj][n] = *(const f32x4*)(g2 + c00 + bj * 128 + 4 * n);
#pragma unroll
        for (int ai = 0; ai < 2; ++ai) {
            u32x2 hv[4][2][2];
#pragma unroll
            for (int m = 0; m < 4; ++m)
#pragma unroll
                for (int bj = 0; bj < 2; ++bj)
#pragma unroll
                    for (int n = 0; n < 2; ++n) hv[m][bj][n] = *(const u32x2*)(out + (size_t)(r0 + ai * 128 + m * 16) * 1024 + c00 + bj * 128 + 4 * n);
#pragma unroll
            for (int m = 0; m < 4; ++m) {
                const size_t r = (size_t)(r0 + ai * 128 + m * 16);
                float sq = 0.f;
#pragma unroll
                for (int bj = 0; bj < 2; ++bj)
#pragma unroll
                    for (int n = 0; n < 2; ++n) {
                        const u32x2 hq = hv[m][bj][n];
                        const f32x4 h = (f32x4){bflo(hq.x), bfhi(hq.x), bflo(hq.y), bfhi(hq.y)} + gv[bj][n] * acc[ai][bj][m][n];
                        { u32x2 hw; hw.x = cvt_pk_bf16(h[0], h[1]); hw.y = cvt_pk_bf16(h[2], h[3]); *(u32x2*)(out + r * 1024 + c00 + bj * 128 + 4 * n) = hw; }
                        sq += h[0] * h[0] + h[1] * h[1] + h[2] * h[2] + h[3] * h[3];
                    }
                sq = xsum16(xsum32(sq));
                if (fq == 0) ss[r * 16 + u.pn * 4 + wc] = sq;
            }
        }
    }
};

struct Params {
    const float *x, *c, *ctx, *c_ctx, *w_mod, *b_mod, *attn_g, *ffn_g, *w_in, *rpb, *lam_re, *lam_im, *log_dt, *b_re, *b_im, *c_re, *c_im, *ssm_d,
        *w_glu, *w_ba, *w_bs, *w_out, *w_fi, *w_fo, *final_g;
    float* out; unsigned char* ws;
    int ph_lo, ph_hi;
};

__device__ __forceinline__ void sincos_d(double a, float& s, float& c) {
    const double inv2pi = 0.15915494309189533577, twopi = 6.283185307179586477;
    double x = a - twopi * __builtin_rint(a * inv2pi);
    const double x2 = x * x;
    double ts = 1.0, tc = 1.0;
    ts = 1.0; tc = 1.0;
#pragma unroll
    for (int k = 13; k >= 1; --k) { ts = 1.0 - x2 * ts * (1.0 / (double)((2 * k) * (2 * k + 1))); tc = 1.0 - x2 * tc * (1.0 / (double)((2 * k - 1) * (2 * k))); }
    s = (float)(x * ts); c = (float)tc;
}

__device__ void tr_strip(const float* __restrict__ src, int N, int K, int ks, int nt, bf16_t* __restrict__ dst, int half, unsigned short* T) {
    const int tid = threadIdx.x;
    { const int n = tid & 63, kb = tid >> 6; float v[32];
      const float* sp = src + (size_t)(ks * 256 + kb) * N + nt * 64 + n;
#pragma unroll
      for (int i = 0; i < 32; ++i) v[i] = sp[(size_t)(8 * i) * N];
#pragma unroll
      for (int i = 0; i < 32; ++i) T[(kb + 8 * i) * 66 + n] = f2bf(v[i]); }
    __syncthreads();
    { const int nn = tid >> 3, kc = (tid & 7) * 8; const int ncol = nt * 64 + nn;
      int drow = ncol;
      if (half) drow = ncol < half ? ((ncol >> 7) * 256 + (ncol & 127)) : (((ncol - half) >> 7) * 256 + 128 + ((ncol - half) & 127));
#pragma unroll
      for (int q = 0; q < 4; ++q) { const int kk = q * 64 + kc; unsigned short v[8];
#pragma unroll
        for (int j = 0; j < 8; ++j) v[j] = T[(kk + j) * 66 + nn];
        u32x4 w; w.x = v[0] | ((unsigned)v[1] << 16); w.y = v[2] | ((unsigned)v[3] << 16); w.z = v[4] | ((unsigned)v[5] << 16); w.w = v[6] | ((unsigned)v[7] << 16);
        *(u32x4*)(dst + (size_t)drow * K + ks * 256 + kk) = w; } }
    __syncthreads();
}

template <int NR>
__device__ void gemv_tile(const float* __restrict__ W, int N, int n0, const float* A_lds, float* red, float (&res)[2], int (&ridx)[2]) {
    const int tid = threadIdx.x, col = tid & 63, ks = tid >> 6;
    float acc[NR];
#pragma unroll
    for (int r = 0; r < NR; ++r) acc[r] = 0.f;
    const float* wp = W + (size_t)(ks * 128) * N + n0 + col;
#pragma unroll 16
    for (int k = 0; k < 128; ++k) { const float w = wp[(size_t)k * N];
#pragma unroll
        for (int r = 0; r < NR; ++r) acc[r] += A_lds[r * 1024 + ks * 128 + k] * w; }
#pragma unroll
    for (int r = 0; r < NR; ++r) red[(ks * NR + r) * 64 + col] = acc[r];
    __syncthreads();
#pragma unroll
    for (int e = 0; e < 2; ++e) { const int idx = tid + e * 512; ridx[e] = idx; float s = 0.f;
        if (idx < NR * 64) { const int r = idx >> 6, cc = idx & 63;
#pragma unroll
            for (int k8 = 0; k8 < 8; ++k8) s += red[(k8 * NR + r) * 64 + cc]; }
        res[e] = s; }
    __syncthreads();
}

__device__ void s5_build(const Params& P, int g, float* L) {
    float* lbp = L; float* Bb = L + 4352; float* Cc = L + 8448; float* Kt = L + 12544;
    const int tid = threadIdx.x;
#pragma unroll 5
    for (int idx = tid; idx < 2 * 17 * 64; idx += 512) {
        const int p = idx & 63, d = (idx >> 6) % 17, dir = idx / (17 * 64);
        const float dt = expf(P.log_dt[dir * 32 + g]);
        const float lr = P.lam_re[(dir * 32 + g) * 64 + p], li = P.lam_im[(dir * 32 + g) * 64 + p];
        const float mag = expf(lr * dt * (float)d); float s, c; sincos_d((double)li * (double)dt * (double)d, s, c);
        lbp[((dir * 17 + d) * 64 + p) * 2] = mag * c; lbp[((dir * 17 + d) * 64 + p) * 2 + 1] = mag * s;
    }
#pragma unroll 4
    for (int idx = tid; idx < 2 * 16 * 64; idx += 512) {
        const int p = idx & 63, h = (idx >> 6) & 15, dir = idx >> 10;
        Cc[((dir * 64 + p) * 16 + h) * 2] = P.c_re[((dir * 32 + g) * 16 + h) * 64 + p]; Cc[((dir * 64 + p) * 16 + h) * 2 + 1] = P.c_im[((dir * 32 + g) * 16 + h) * 64 + p];
    }
    __syncthreads();
#pragma unroll 4
    for (int idx = tid; idx < 2 * 64 * 16; idx += 512) {
        const int h = idx & 15, p = (idx >> 4) & 63, dir = idx >> 10;
        const float lr = P.lam_re[(dir * 32 + g) * 64 + p], li = P.lam_im[(dir * 32 + g) * 64 + p];
        const float nr = lbp[((dir * 17 + 1) * 64 + p) * 2] - 1.0f, ni = lbp[((dir * 17 + 1) * 64 + p) * 2 + 1];
        const float den = lr * lr + li * li;
        const float fre = (nr * lr + ni * li) / den, fim = (ni * lr - nr * li) / den;
        const float br = P.b_re[((dir * 32 + g) * 64 + p) * 16 + h], bi = P.b_im[((dir * 32 + g) * 64 + p) * 16 + h];
        Bb[((dir * 64 + p) * 16 + h) * 2] = fre * br - fim * bi; Bb[((dir * 64 + p) * 16 + h) * 2 + 1] = fre * bi + fim * br;
    }
    if (tid < 128) { const int p = tid & 63, dir = tid >> 6;
        ((f32x2*)(P.ws + WS_LBT))[(dir * 32 + g) * 64 + p] = (f32x2){lbp[((dir * 17 + 16) * 64 + p) * 2], lbp[((dir * 17 + 16) * 64 + p) * 2 + 1]}; }
    __syncthreads();
    { const int h = tid & 15, d = (tid >> 4) & 15, dir = tid >> 8;
      float ak[16];
#pragma unroll
      for (int j = 0; j < 16; ++j) ak[j] = 0.f;
      for (int p = 0; p < 64; ++p) {
          const f32x2 cc = *(const f32x2*)(Cc + ((dir * 64 + p) * 16 + h) * 2), zz = *(const f32x2*)(lbp + ((dir * 17 + d) * 64 + p) * 2);
          const float czr = cc.x * zz.x - cc.y * zz.y, czi = cc.x * zz.y + cc.y * zz.x;
          const f32x4* bp = (const f32x4*)(Bb + (dir * 64 + p) * 32);
#pragma unroll
          for (int j4 = 0; j4 < 8; ++j4) { const f32x4 bq = bp[j4]; ak[2 * j4] += czr * bq[0] - czi * bq[1]; ak[2 * j4 + 1] += czr * bq[2] - czi * bq[3]; }
      }
#pragma unroll
      for (int j = 0; j < 16; ++j) Kt[((dir * 16 + d) * 16 + h) * 16 + j] = ak[j]; }
    __syncthreads();
    bf16_t* W1 = (bf16_t*)(P.ws + WS_S5W1) + (size_t)g * 256 * 256;
    for (int v = tid; v < 256 * 32; v += 512) {
        const int n = v >> 5, k0 = (v & 31) * 8, dir = n >> 7, p = (n >> 1) & 63, ri = n & 1, s = k0 >> 4, h0 = k0 & 15;
        const int d = dir ? s : 15 - s;
        const float zr = lbp[((dir * 17 + d) * 64 + p) * 2], zi = lbp[((dir * 17 + d) * 64 + p) * 2 + 1];
        float o[8];
#pragma unroll
        for (int j = 0; j < 8; ++j) { const float br = Bb[((dir * 64 + p) * 16 + h0 + j) * 2], bi = Bb[((dir * 64 + p) * 16 + h0 + j) * 2 + 1];
            o[j] = ri ? (zr * bi + zi * br) : (zr * br - zi * bi); }
        u32x4 w; w.x = cvt_pk_bf16(o[0], o[1]); w.y = cvt_pk_bf16(o[2], o[3]); w.z = cvt_pk_bf16(o[4], o[5]); w.w = cvt_pk_bf16(o[6], o[7]);
        *(u32x4*)(W1 + (size_t)n * 256 + k0) = w;
    }
    bf16_t* M2 = (bf16_t*)(P.ws + WS_S5M2) + (size_t)g * 256 * 512;
    for (int v = tid; v < 256 * 64; v += 512) {
        const int n = v & 255, k0 = (v >> 8) * 8, t = n >> 4, h = n & 15;
        float o[8];
        if (k0 < 256) { const int s = k0 >> 4, h0 = k0 & 15;
#pragma unroll
            for (int j = 0; j < 8; ++j) { float a = 0.f;
                if (s <= t) a += Kt[((0 * 16 + (t - s)) * 16 + h) * 16 + h0 + j];
                if (s >= t) a += Kt[((1 * 16 + (s - t)) * 16 + h) * 16 + h0 + j];
                o[j] = a; }
        } else { const int dir = (k0 - 256) >> 7, kk = (k0 - 256) & 127, d = dir ? 16 - t : t + 1;
#pragma unroll
            for (int j = 0; j < 8; ++j) { const int p = (kk + j) >> 1, ri = (kk + j) & 1;
                const float cr = Cc[((dir * 64 + p) * 16 + h) * 2], ci = Cc[((dir * 64 + p) * 16 + h) * 2 + 1];
                const float zr = lbp[((dir * 17 + d) * 64 + p) * 2], zi = lbp[((dir * 17 + d) * 64 + p) * 2 + 1];
                o[j] = ri ? -(cr * zi + ci * zr) : (cr * zr - ci * zi); }
        }
        u32x4 w; w.x = cvt_pk_bf16(o[0], o[1]); w.y = cvt_pk_bf16(o[2], o[3]); w.z = cvt_pk_bf16(o[4], o[5]); w.w = cvt_pk_bf16(o[6], o[7]);
        *(u32x4*)(M2 + (size_t)n * 512 + k0) = w;
    }
    __syncthreads();
}

__device__ __forceinline__ void norm_rows2(const Params& P, int rowa, int rowb, int lane) {
    const float* mod = (const float*)(P.ws + WS_MOD);
    bf16_t* nb = (bf16_t*)(P.ws + WS_A);
    const int rows[2] = {rowa, rowb};
    f32x4 v[2][4];
#pragma unroll
    for (int q = 0; q < 2; ++q) { const int row = rows[q];
        const float* src = row < MLAT ? P.x + (size_t)row * 1024 : P.ctx + (size_t)(row - MLAT) * 1024;
#pragma unroll
        for (int i = 0; i < 4; ++i) v[q][i] = __builtin_nontemporal_load((const f32x4*)(src + 4 * lane + 256 * i)); }
#pragma unroll
    for (int q = 0; q < 2; ++q) { const int row = rows[q];
        const int mr = row < MLAT ? (row >> 12) : 8;
        const float* sh = mod + mr * 6144; const float* sc = sh + 1024;
        float ss = 0.f;
#pragma unroll
        for (int i = 0; i < 4; ++i) ss += v[q][i][0] * v[q][i][0] + v[q][i][1] * v[q][i][1] + v[q][i][2] * v[q][i][2] + v[q][i][3] * v[q][i][3];
#pragma unroll
        for (int o = 32; o >= 1; o >>= 1) ss += __shfl_xor(ss, o);
        const float rstd = 1.0f / sqrtf(ss * (1.0f / 1024.0f) + NORM_EPS);
#pragma unroll
        for (int i = 0; i < 4; ++i) { const int c = 4 * lane + 256 * i;
            const f32x4 gv = *(const f32x4*)(P.attn_g + c), sv = *(const f32x4*)(sc + c), hv = *(const f32x4*)(sh + c);
            const f32x4 o = v[q][i] * rstd * gv * (sv + 1.0f) + hv;
            u32x2 w; w.x = cvt_pk_bf16(o[0], o[1]); w.y = cvt_pk_bf16(o[2], o[3]);
            *(u32x2*)(nb + (size_t)row * 1024 + c) = w; } }
}

struct TrDesc { const float* src; bf16_t* dst; int N, K, half, nstrip_k, nitems; };

__device__ void phase0(const Params& P, unsigned char* lds) {
    const int tid = threadIdx.x;
    float* Lf = (float*)lds;
    int* qslot = (int*)(lds + 100 * 1024);
    unsigned* queue = (unsigned*)(P.ws + WS_BAR) + 64;
    TrDesc td[7] = {
        {P.w_in, (bf16_t*)(P.ws + WS_WIN), INC, DM, 0, DM / 256, (INC / 64) * (DM / 256)},
        {P.w_glu, (bf16_t*)(P.ws + WS_WGLU), 2 * SW, SW, SW, SW / 256, ((2 * SW) / 64) * (SW / 256)},
        {P.w_ba, (bf16_t*)(P.ws + WS_WBA), DM, AW, 0, AW / 256, (DM / 64) * (AW / 256)},
        {P.w_bs, (bf16_t*)(P.ws + WS_WBS), DM, SW, 0, SW / 256, (DM / 64) * (SW / 256)},
        {P.w_out, (bf16_t*)(P.ws + WS_WOUT), DM, DM, 0, DM / 256, (DM / 64) * (DM / 256)},
        {P.w_fi, (bf16_t*)(P.ws + WS_WFI), 2 * FH, DM, FH, DM / 256, ((2 * FH) / 64) * (DM / 256)},
        {P.w_fo, (bf16_t*)(P.ws + WS_WFO), DM, FH, 0, FH / 256, (DM / 64) * (FH / 256)}};
    int ntr = 0;
#pragma unroll
    for (int i = 0; i < 7; ++i) ntr += td[i].nitems;
    const int NI = 32 + 96 + 1 + ntr + 128;
    unsigned* modcnt = (unsigned*)(P.ws + WS_BAR) + 128;
    for (;;) {
        __syncthreads();
        if (tid == 0) *qslot = (int)atomicAdd(queue, 1u);
        __syncthreads();
        const int it = *qslot;
        if (it >= NI) break;
        if (it >= 32 && it < 64) {
            s5_build(P, it - 32, Lf);
        } else if (it < 128) {
            const int mt = it < 32 ? it : it - 32;
            for (int idx = tid; idx < 9 * 1024; idx += 512) { const float v = idx < 8192 ? P.c[idx] : P.c_ctx[idx - 8192]; Lf[idx] = v * fast_sigmoid(v); }
            __syncthreads();
            float res[2]; int ridx[2];
            gemv_tile<9>(P.w_mod, 6 * DM, mt * 64, Lf, Lf + 9 * 1024, res, ridx);
#pragma unroll
            for (int e = 0; e < 2; ++e) if (ridx[e] < 9 * 64) { const int r = ridx[e] >> 6, cc = ridx[e] & 63; ((float*)(P.ws + WS_MOD))[r * 6144 + mt * 64 + cc] = res[e] + P.b_mod[mt * 64 + cc]; }
            if (mt < 32) {
                asm volatile("s_waitcnt vmcnt(0)" ::: "memory"); __syncthreads();
                if (tid == 0) { __builtin_amdgcn_fence(__ATOMIC_RELEASE, "agent"); asm volatile("s_waitcnt vmcnt(0)" ::: "memory");
                    __hip_atomic_fetch_add(modcnt, 1u, __ATOMIC_RELAXED, __HIP_MEMORY_SCOPE_AGENT); }
            }
        } else if (it == 128) {
            for (int idx = tid; idx < 1024; idx += 512) { const int pos = idx >> 4, i = idx & 15;
                const float invf = expf(-(float)i * (1.0f / 16.0f) * 9.210340371976184f);
                float sn, cs; sincos_d((double)((float)pos * invf), sn, cs);
                ((f32x2*)(P.ws + WS_ROPE))[idx] = (f32x2){cs, sn}; }
        } else if (it >= 129 + ntr) {
            if (tid == 0) { unsigned spins = 0;
                while (__hip_atomic_load(modcnt, __ATOMIC_RELAXED, __HIP_MEMORY_SCOPE_AGENT) < 32u) { __builtin_amdgcn_s_sleep(4); if (++spins > (1u << 22)) break; }
                __builtin_amdgcn_fence(__ATOMIC_ACQUIRE, "agent"); asm volatile("s_waitcnt vmcnt(0)" ::: "memory"); }
            __syncthreads();
            const int base = MLAT + (it - 129 - ntr) * 16, wave = tid >> 6;
            norm_rows2(P, base + wave, base + 8 + wave, tid & 63);
        } else {
            int j = it - 129, w = 0;
#pragma unroll
            for (int i = 0; i < 6; ++i) if (w == i && j >= td[i].nitems) { j -= td[i].nitems; w = i + 1; }
            const float* src = td[0].src; bf16_t* dst = td[0].dst; int N = td[0].N, K = td[0].K, half = td[0].half, nk = td[0].nstrip_k;
#pragma unroll
            for (int i = 1; i < 7; ++i) if (w == i) { src = td[i].src; dst = td[i].dst; N = td[i].N; K = td[i].K; half = td[i].half; nk = td[i].nstrip_k; }
            tr_strip(src, N, K, j % nk, j / nk, dst, half, (unsigned short*)lds);
        }
    }
}

__device__ void phase1(const Params& P, unsigned char* lds) {
    const int tid = threadIdx.x, G = gridDim.x, lane = tid & 63, wave = tid >> 6;
    float* Lf = (float*)lds;
    const float* mod = (const float*)(P.ws + WS_MOD);
    for (int it = blockIdx.x; it < 88; it += G) {
        for (int idx = tid; idx < 8 * 1024; idx += 512) Lf[idx] = mod[(idx >> 10) * 6144 + 3 * 1024 + (idx & 1023)];
        __syncthreads();
        float res[2]; int ridx[2];
        gemv_tile<8>(P.w_fi, 2 * FH, it * 64, Lf, Lf + 8 * 1024, res, ridx);
        if (ridx[0] < 8 * 64) { const int r = ridx[0] >> 6, ncol = it * 64 + (ridx[0] & 63);
            const int drow = ncol < FH ? ((ncol >> 7) * 256 + (ncol & 127)) : (((ncol - FH) >> 7) * 256 + 128 + ((ncol - FH) & 127));
            ((float*)(P.ws + WS_BIAS2))[r * 5632 + drow] = res[0]; }
    }
    const int NBR = G > 96 ? G - 48 : G;
    for (int row0 = blockIdx.x * 8 + wave; row0 < MLAT; row0 += NBR * 16) {
        const int rb = row0 + NBR * 8;
        norm_rows2(P, row0, rb < MLAT ? rb : row0, lane);
    }
}

__device__ __forceinline__ void scan_task(const Params& P, int task, int lane) {
    const int g = task >> 4, dir = (task >> 3) & 1, b = task & 7, p = lane;
    const f32x2 lb = ((const f32x2*)(P.ws + WS_LBT))[(dir * 32 + g) * 64 + p];
    const float* __restrict__ Eg = (const float*)(P.ws + WS_E) + (size_t)g * XH_ROWS * 256 + dir * 128 + 2 * p;
    unsigned* __restrict__ xh = (unsigned*)((bf16_t*)(P.ws + WS_D) + (size_t)g * XH_ROWS * 512 + 256 + dir * 128 + 2 * p);
    float hr = 0.f, hi = 0.f;
    f32x2 e[16];
#pragma unroll
    for (int i = 0; i < 16; ++i) { const int cc = dir ? 15 - i : i; e[i] = *(const f32x2*)(Eg + (size_t)(2048 + b * 16 + cc) * 256); }
#pragma unroll
    for (int i = 0; i < 16; ++i) { const float nr = lb.x * hr - lb.y * hi + e[i].x, ni = lb.x * hi + lb.y * hr + e[i].y; hr = nr; hi = ni; }
    f32x2 en[32];
#pragma unroll
    for (int i = 0; i < 32; ++i) { const int c = dir ? 255 - i : i; en[i] = *(const f32x2*)(Eg + (size_t)(b * 256 + c) * 256); }
#pragma unroll 1
    for (int blk = 0; blk < 8; ++blk) {
        f32x2 ec[32];
#pragma unroll
        for (int i = 0; i < 32; ++i) ec[i] = en[i];
        if (blk < 7) {
#pragma unroll
            for (int i = 0; i < 32; ++i) { const int ci = (blk + 1) * 32 + i; const int c = dir ? 255 - ci : ci; en[i] = *(const f32x2*)(Eg + (size_t)(b * 256 + c) * 256); }
        }
#pragma unroll
        for (int i = 0; i < 32; ++i) { const int ci = blk * 32 + i; const int c = dir ? 255 - ci : ci;
            xh[(size_t)(b * 256 + c) * 256] = cvt_pk_bf16(hr, hi);
            const float nr = lb.x * hr - lb.y * hi + ec[i].x, ni = lb.x * hi + lb.y * hr + ec[i].y; hr = nr; hi = ni; }
    }
}

constexpr int ATT_LK = 0, ATT_LV = 256 * 144, ATT_LB = ATT_LV + 32768, ATT_LC = ATT_LB + 2048;

template <bool LOC, int NT>
__device__ __forceinline__ void att_sm_pv(f32x4 (&s)[NT], const bf16x8 (&vv)[NT / 2][4], f32x4 (&o)[5], float& mrun,
                                          const float* rpbl, const int (&dcl)[8], unsigned inw, int dr) {
    const float SC = 0.125f * LOG2E;
    float mnew;
    if (LOC) {
        float mx = -1e30f;
#pragma unroll
        for (int tile = 0; tile < NT; ++tile)
#pragma unroll
            for (int j = 0; j < 4; ++j) { const int jj = 4 * (tile & 1) + j;
                const float bv = rpbl[dr * 31 + dcl[jj]];
                const float tv = __builtin_fmaf(s[tile][j], SC, bv);
                const float v = ((inw >> jj) & 1u) ? tv : -1e30f;
                s[tile][j] = v; mx = fmaxf(mx, v); }
        mx = xmax16(xmax32(mx));
        mnew = fmaxf(mrun, mx);
#pragma unroll
        for (int tile = 0; tile < NT; ++tile)
#pragma unroll
            for (int j = 0; j < 4; ++j) s[tile][j] = __builtin_amdgcn_exp2f(s[tile][j] - mnew);
    } else {
        float mx = -1e30f;
#pragma unroll
        for (int tile = 0; tile < NT; ++tile)
#pragma unroll
            for (int j = 0; j < 4; ++j) mx = fmaxf(mx, s[tile][j]);
        mx = xmax16(xmax32(mx)) * SC;
        mnew = fmaxf(mrun, mx);
#pragma unroll
        for (int tile = 0; tile < NT; ++tile)
#pragma unroll
            for (int j = 0; j < 4; ++j) s[tile][j] = __builtin_amdgcn_exp2f(__builtin_fmaf(s[tile][j], SC, -mnew));
    }
    if (__builtin_amdgcn_ballot_w64(mnew > mrun) != 0ull) {
        const float alpha = __builtin_amdgcn_exp2f(mrun - mnew);
#pragma unroll
        for (int d = 0; d < 5; ++d) o[d] *= alpha;
    }
    mrun = mnew;
    const bf16x8 ones = {(short)0x3F80, (short)0x3F80, (short)0x3F80, (short)0x3F80, (short)0x3F80, (short)0x3F80, (short)0x3F80, (short)0x3F80};
#pragma unroll
    for (int kb2 = 0; kb2 < NT / 2; ++kb2) {
        u32x4 pw; pw.x = cvt_pk_bf16(s[2 * kb2][0], s[2 * kb2][1]); pw.y = cvt_pk_bf16(s[2 * kb2][2], s[2 * kb2][3]);
        pw.z = cvt_pk_bf16(s[2 * kb2 + 1][0], s[2 * kb2 + 1][1]); pw.w = cvt_pk_bf16(s[2 * kb2 + 1][2], s[2 * kb2 + 1][3]);
        bf16x8 pb; __builtin_memcpy(&pb, &pw, 16);
#pragma unroll
        for (int d = 0; d < 4; ++d) o[d] = __builtin_amdgcn_mfma_f32_16x16x32_bf16(vv[kb2][d], pb, o[d], 0, 0, 0);
        o[4] = __builtin_amdgcn_mfma_f32_16x16x32_bf16(ones, pb, o[4], 0, 0, 0);
    }
}

__device__ __forceinline__ void attn_task2(const Params& P, int b, int h, int rA, int cb, int lane, const float* rpbl, const LAS unsigned char* ldsl) {
    const int n = lane & 15, g4 = lane >> 4;
    const bf16_t* qb = (const bf16_t*)(P.ws + WS_B);
    const bf16_t* kb = (const bf16_t*)(P.ws + WS_C);
    const bf16_t* vt = kb + (size_t)MALL * 512;
    bf16_t* ab = (bf16_t*)(P.ws + WS_A);
    const int tqA = rA * 64 + cb * 16 + n;
    const bf16_t* qp = qb + ((size_t)(b * 4096 + tqA)) * 512 + h * 64 + 8 * g4;
    const bf16x8 qA0 = *(const bf16x8*)qp, qA1 = *(const bf16x8*)(qp + 32), qB0 = *(const bf16x8*)(qp + 64 * 512), qB1 = *(const bf16x8*)(qp + 64 * 512 + 32);
    const int rsA = min(max(rA - 4, 0), 56), rsB = min(max(rA - 3, 0), 56), bs = min(max(16 * cb - 8, 0), 32);
    const int qcol = 16 * cb + n, cst = min(max(qcol - 8, 0), 48);
    int dcl[8]; unsigned inw = 0;
#pragma unroll
    for (int jj = 0; jj < 8; ++jj) { const int kcol = bs + 8 * g4 + jj; if (kcol >= cst && kcol < cst + 16) inw |= 1u << jj; dcl[jj] = min(max(kcol - qcol, -15), 15) + 15; }
    f32x4 oA[5], oB[5];
#pragma unroll
    for (int d = 0; d < 5; ++d) { oA[d] = (f32x4){0.f, 0.f, 0.f, 0.f}; oB[d] = (f32x4){0.f, 0.f, 0.f, 0.f}; }
    float mA = -1e30f, mB = -1e30f;
    const int kx = 8 * (n >> 2) + (n & 3);
    const bf16_t* kloc = kb + ((size_t)b * 4096 + bs + kx) * 512 + h * 64 + 8 * g4;
    const bf16_t* vloc = vt + ((size_t)(b * 8 + h) * 512 + bs / 8 + g4) * 512 + n * 8;
    bf16x8 kc[2][2], kn[2][2], vc[1][4], vn[1][4];
#define ATT_LOADROW(kd, vd, row) do { _Pragma("unroll") for (int tile = 0; tile < 2; ++tile) { \
        const bf16_t* kp_ = kloc + (size_t)(row) * (64 * 512) + tile * (4 * 512); kd[tile][0] = *(const bf16x8*)kp_; kd[tile][1] = *(const bf16x8*)(kp_ + 32); } \
        _Pragma("unroll") for (int d = 0; d < 4; ++d) vd[0][d] = *(const bf16x8*)(vloc + (size_t)(row) * (8 * 512) + d * 128); } while (0)
    ATT_LOADROW(kc, vc, rsA);
    const LAS unsigned char* lk = ldsl + ATT_LK + kx * 144 + g4 * 16;
    const LAS unsigned char* lv = ldsl + ATT_LV + (g4 * 64 + n) * 16;
#pragma unroll 1
    for (int step = 0; step < 8; ++step) {
        f32x4 sA[2], sB[2]; bf16x8 vl[1][4];
#pragma unroll
        for (int tile = 0; tile < 2; ++tile) {
            const LAS unsigned char* kp = lk + step * (32 * 144) + tile * (4 * 144);
            const bf16x8 k0 = *(const LAS bf16x8*)kp, k1 = *(const LAS bf16x8*)(kp + 64);
            sA[tile] = __builtin_amdgcn_mfma_f32_16x16x32_bf16(k0, qA0, (f32x4){0.f, 0.f, 0.f, 0.f}, 0, 0, 0);
            sA[tile] = __builtin_amdgcn_mfma_f32_16x16x32_bf16(k1, qA1, sA[tile], 0, 0, 0);
            sB[tile] = __builtin_amdgcn_mfma_f32_16x16x32_bf16(k0, qB0, (f32x4){0.f, 0.f, 0.f, 0.f}, 0, 0, 0);
            sB[tile] = __builtin_amdgcn_mfma_f32_16x16x32_bf16(k1, qB1, sB[tile], 0, 0, 0);
        }
#pragma unroll
        for (int d = 0; d < 4; ++d) vl[0][d] = *(const LAS bf16x8*)(lv + step * 4096 + d * 256);
        att_sm_pv<false, 2>(sA, vl, oA, mA, rpbl, dcl, inw, 0);
        att_sm_pv<false, 2>(sB, vl, oB, mB, rpbl, dcl, inw, 0);
    }
    const int klast = rsB + 7;
#pragma unroll 1
    for (int k = rsA; k <= klast; ++k) {
        if (k < klast) ATT_LOADROW(kn, vn, k + 1);
        if (k < rsA + 8) {
            f32x4 s[2];
#pragma unroll
            for (int tile = 0; tile < 2; ++tile) {
                s[tile] = __builtin_amdgcn_mfma_f32_16x16x32_bf16(kc[tile][0], qA0, (f32x4){0.f, 0.f, 0.f, 0.f}, 0, 0, 0);
                s[tile] = __builtin_amdgcn_mfma_f32_16x16x32_bf16(kc[tile][1], qA1, s[tile], 0, 0, 0); }
            att_sm_pv<true, 2>(s, vc, oA, mA, rpbl, dcl, inw, k - rA + 7);
        }
        if (k >= rsB) {
            f32x4 s[2];
#pragma unroll
            for (int tile = 0; tile < 2; ++tile) {
                s[tile] = __builtin_amdgcn_mfma_f32_16x16x32_bf16(kc[tile][0], qB0, (f32x4){0.f, 0.f, 0.f, 0.f}, 0, 0, 0);
                s[tile] = __builtin_amdgcn_mfma_f32_16x16x32_bf16(kc[tile][1], qB1, s[tile], 0, 0, 0); }
            att_sm_pv<true, 2>(s, vc, oB, mB, rpbl, dcl, inw, k - (rA + 1) + 7);
        }
#pragma unroll
        for (int tile = 0; tile < 2; ++tile) { kc[tile][0] = kn[tile][0]; kc[tile][1] = kn[tile][1]; }
#pragma unroll
        for (int d = 0; d < 4; ++d) vc[0][d] = vn[0][d];
    }
#undef ATT_LOADROW
    const float invA = 1.0f / oA[4][0], invB = 1.0f / oB[4][0];
    bf16_t* op = ab + ((size_t)(b * 4096 + tqA)) * 512 + h * 64 + 4 * g4;
#pragma unroll
    for (int d = 0; d < 4; ++d) {
        u32x2 w; w.x = cvt_pk_bf16(oA[d][0] * invA, oA[d][1] * invA); w.y = cvt_pk_bf16(oA[d][2] * invA, oA[d][3] * invA); *(u32x2*)(op + 16 * d) = w;
        u32x2 w2; w2.x = cvt_pk_bf16(oB[d][0] * invB, oB[d][1] * invB); w2.y = cvt_pk_bf16(oB[d][2] * invB, oB[d][3] * invB); *(u32x2*)(op + 64 * 512 + 16 * d) = w2; }
}

__device__ void phase4(const Params& P, unsigned char* lds) {
    const int tid = threadIdx.x, G = gridDim.x, lane = tid & 63, wave = tid >> 6;
    const LAS unsigned char* ldsl = (const LAS unsigned char*)lds;
    float* rpbl = (float*)(lds + ATT_LB);
    int* ctr = (int*)(lds + ATT_LC);
    if (wave < 2) for (int task = blockIdx.x * 2 + wave; task < 512; task += G * 2) scan_task(P, task, lane);
    const bf16_t* kb = (const bf16_t*)(P.ws + WS_C);
    const bf16_t* vtc = kb + (size_t)MALL * 512 + (size_t)MLAT * 512;
    for (int bt = blockIdx.x; bt < 256; bt += G) {
        const int xcd = bt & 7, j = bt >> 3, pair = xcd * 8 + (j >> 2), quarter = j & 3, b = pair >> 3, h = pair & 7;
        __syncthreads();
        for (int idx = tid; idx < 15 * 31; idx += 512) rpbl[idx] = P.rpb[h * 465 + idx] * LOG2E;
        if (tid == 0) *ctr = 0;
#pragma unroll 1
        for (int i = 0; i < 4; ++i) { const int e = tid + 512 * i, key = e >> 3, ch = e & 7;
            const u32x4 kvv = *(const u32x4*)(kb + ((size_t)MLAT + b * 256 + key) * 512 + h * 64 + ch * 8);
            *(u32x4*)(lds + ATT_LK + key * 144 + ch * 16) = kvv;
            const u32x4 vvv = *(const u32x4*)(vtc + (size_t)(b * 8 + h) * 32 * 512 + (size_t)e * 8);
            *(u32x4*)(lds + ATT_LV + e * 16) = vvv; }
        __syncthreads();
        for (;;) {
            int t = 0; if (lane == 0) t = atomicAdd(ctr, 1);
            t = __shfl(t, 0);
            if (t >= 32) break;
            attn_task2(P, b, h, quarter * 16 + 2 * (t >> 2), t & 3, lane, rpbl, ldsl);
        }
    }
}

__device__ void phase_final(const Params& P) {
    const int tid = threadIdx.x, G = gridDim.x, lane = tid & 63, wave = tid >> 6;
    const float* ss = (const float*)(P.ws + WS_SSP2);
    const bf16_t* hb = (const bf16_t*)(P.ws + WS_F);
    for (int row0 = blockIdx.x * 8 + wave; row0 < MLAT; row0 += G * 16) {
        const int rows[2] = {row0, row0 + G * 8};
        u32x2 hq[2][4]; f32x4 sp[2];
#pragma unroll
        for (int q = 0; q < 2; ++q) { const int row = rows[q] < MLAT ? rows[q] : row0;
            sp[q] = *(const f32x4*)(ss + (size_t)row * 16 + 4 * (lane & 3));
#pragma unroll
            for (int i = 0; i < 4; ++i) hq[q][i] = __builtin_nontemporal_load((const u32x2*)(hb + (size_t)row * 1024 + 4 * lane + 256 * i)); }
#pragma unroll
        for (int q = 0; q < 2; ++q) { const int row = rows[q]; if (row >= MLAT) continue;
            float t = (sp[q][0] + sp[q][1]) + (sp[q][2] + sp[q][3]); t += __shfl_xor(t, 1); t += __shfl_xor(t, 2);
            const float rstd = 1.0f / sqrtf(t * (1.0f / 1024.0f) + NORM_EPS);
#pragma unroll
            for (int i = 0; i < 4; ++i) { const int c = 4 * lane + 256 * i;
                const f32x4 v = (f32x4){bflo(hq[q][i].x), bfhi(hq[q][i].x), bflo(hq[q][i].y), bfhi(hq[q][i].y)}, gv = *(const f32x4*)(P.final_g + c);
                __builtin_nontemporal_store(v * rstd * gv, (f32x4*)(P.out + (size_t)row * 1024 + c)); } }
    }
}

#define XB_TMO      128
#define XB_XCNT(j)  (256  + 64 * (j))
#define XB_XSUB(j)  (1280 + 64 * (j))
#define XB_XGEN(j)  (2304 + 64 * (j))
#define XB_TOP      3328
#define XB_TOPGEN   3392
#define XCD_BAR_WORDS 3456
#define XB_SPIN_CAP (1u << 18)

__device__ __forceinline__ unsigned xb_ld(unsigned* p)              { return __hip_atomic_load(p, __ATOMIC_RELAXED, __HIP_MEMORY_SCOPE_AGENT); }
__device__ __forceinline__ unsigned xb_add(unsigned* p, unsigned v) { return __hip_atomic_fetch_add(p, v, __ATOMIC_RELAXED, __HIP_MEMORY_SCOPE_AGENT); }
__device__ __forceinline__ unsigned xb_xcc_id() { return (unsigned)__builtin_amdgcn_s_getreg((3 << 11) | 20) & 0xFu; }
#define XB_SPIN(cond, bar) do { unsigned _sp = 0; while (cond) { __builtin_amdgcn_s_sleep(1); \
    if ((++_sp & 255u) == 0u) { if (xb_ld(&(bar)[XB_TMO])) break; if (_sp > XB_SPIN_CAP) { atomicAdd(&(bar)[XB_TMO], 1u); break; } } } } while (0)

struct XcdBarrier {
    unsigned* bar; unsigned x;
    volatile LAS unsigned* st;
};

__device__ __forceinline__ XcdBarrier xcd_barrier_post(unsigned* bar, volatile LAS unsigned* st) {
    XcdBarrier b; b.bar = bar; b.x = xb_xcc_id(); b.st = st;
    if (threadIdx.x == 0) (void)xb_add(&bar[XB_XCNT(b.x)], 1u);
    return b;
}
__device__ __forceinline__ void xcd_barrier_complete(unsigned* bar, unsigned x, unsigned& nloc, unsigned& nx) {
    const unsigned G = gridDim.x * gridDim.y * gridDim.z;
    unsigned sum, cnt, mine, sp = 0u;
    for (;;) {
        sum = 0u; cnt = 0u; mine = 0u;
#pragma unroll
        for (unsigned j = 0; j < 16; ++j) { const unsigned c = xb_ld(&bar[XB_XCNT(j)]); sum += c; cnt += (c > 0u) ? 1u : 0u; mine = (j == x) ? c : mine; }
        if (sum == G) break;
        __builtin_amdgcn_s_sleep(1);
        if ((++sp & 255u) == 0u) { if (xb_ld(&bar[XB_TMO])) break; if (sp > XB_SPIN_CAP) { atomicAdd(&bar[XB_TMO], 1u); break; } }
    }
    nloc = mine > 0u ? mine : 1u; nx = cnt > 0u ? cnt : 1u;
}

__device__ __forceinline__ void xcd_barrier(const XcdBarrier& b) {
    asm volatile("s_waitcnt vmcnt(0)" ::: "memory");
    __syncthreads();
    if (threadIdx.x == 0) {
        unsigned* bar = b.bar;
        __builtin_amdgcn_s_waitcnt(0);
        unsigned nloc = b.st[0], nx = b.st[1];
        if (nloc == 0u) { xcd_barrier_complete(bar, b.x, nloc, nx); b.st[0] = nloc; b.st[1] = nx; }
        const unsigned old = xb_add(&bar[XB_XSUB(b.x)], 1u);
        const unsigned gen = old / nloc;
        if (old + 1u == (gen + 1u) * nloc) {
            __builtin_amdgcn_fence(__ATOMIC_RELEASE, "agent");
            asm volatile("s_waitcnt vmcnt(0)" ::: "memory");
            const unsigned og = xb_add(&bar[XB_TOP], 1u);
            const unsigned tg = og / nx;
            if (og + 1u == (tg + 1u) * nx) xb_add(&bar[XB_TOPGEN], 1u);
            else XB_SPIN(xb_ld(&bar[XB_TOPGEN]) == tg, bar);
            __builtin_amdgcn_fence(__ATOMIC_ACQUIRE, "agent");
            xb_add(&bar[XB_XGEN(b.x)], 1u);
            asm volatile("s_waitcnt vmcnt(0)" ::: "memory");
        } else {
            XB_SPIN(xb_ld(&bar[XB_XGEN(b.x)]) == gen, bar);
            __builtin_amdgcn_fence(__ATOMIC_ACQUIRE, "agent");
            asm volatile("s_waitcnt vmcnt(0)" ::: "memory");
        }
    }
    __syncthreads();
}

constexpr int LDS_BYTES = pg8::STAGE_BYTES + 16;
constexpr int NPHASE = 12;

__global__ void __launch_bounds__(512, 2) fwd_kernel(Params P) {
    extern __shared__ __attribute__((aligned(16))) unsigned char lds[];
    LAS unsigned char* ldsl = (LAS unsigned char*)lds;
    const int G = gridDim.x, cidx = blockIdx.x;
    const int lo = P.ph_lo, hi = P.ph_hi;
#define IN(k) (lo <= (k) && (k) < hi)
    unsigned* barw = (unsigned*)(P.ws + WS_BAR);
    (void)barw;
    volatile LAS unsigned* xst = (volatile LAS unsigned*)(ldsl + pg8::STAGE_BYTES);
    if (threadIdx.x < 4) xst[threadIdx.x] = 0u;
    __syncthreads();
    const XcdBarrier xbar = xcd_barrier_post((unsigned*)(P.ws + WS_BAR + 4096), xst);
#define SEAM(k) do { if (IN(k) && IN((k) + 1)) { if ((k) == 0) cg::this_grid().sync(); else { xcd_barrier(xbar); } } } while (0)
    bf16_t* ws16 = (bf16_t*)P.ws;
    const float* mod = (const float*)(P.ws + WS_MOD);
    if (IN(0)) { phase0(P, lds); } SEAM(0);
    if (IN(1)) {
        const bool split = G > 96, gemm_wg = !split || cidx >= G - 48;
        if (!split || !gemm_wg) phase1(P, lds);
        if (gemm_wg) {
            if (!split) __syncthreads();
            pg8::Gemm g{(const bf16_t*)(P.ws + WS_A), (const bf16_t*)(P.ws + WS_WIN), DM, DM, DM};
            pg8::CtxOrder S{split ? 48 : G, split ? cidx - (G - 48) : cidx};
            bf16_t* kb = (bf16_t*)(P.ws + WS_C);
            EpiInProj E{(bf16_t*)(P.ws + WS_B), kb, kb + (size_t)MALL * 512, kb + (size_t)MALL * 512 + (size_t)MLAT * 512, (bf16_t*)(P.ws + WS_D), (bf16_t*)(P.ws + WS_F), (const f32x2*)(P.ws + WS_ROPE)};
            pg8::gemm_phase(ldsl, g, S, E);
        }
    } SEAM(1);
    if (IN(2)) {
        pg8::Gemm g{(const bf16_t*)(P.ws + WS_A), (const bf16_t*)(P.ws + WS_WIN), DM, DM, DM};
        pg8::StaticOrder S; S.init(MLAT, INC, G, cidx);
        bf16_t* kb = (bf16_t*)(P.ws + WS_C);
        EpiInProj E{(bf16_t*)(P.ws + WS_B), kb, kb + (size_t)MALL * 512, kb + (size_t)MALL * 512 + (size_t)MLAT * 512, (bf16_t*)(P.ws + WS_D), (bf16_t*)(P.ws + WS_F), (const f32x2*)(P.ws + WS_ROPE)};
        pg8::gemm_phase<EpiInProj, pg8::StaticOrder, true, true>(ldsl, g, S, E);
    } SEAM(2);
    if (IN(3)) {
        pg8::Gemm g{(const bf16_t*)(P.ws + WS_D), (const bf16_t*)(P.ws + WS_S5W1), 512, 256, 256};
        pg8::S5Order<9> S; S.init(G, cidx);
        EpiE E{(float*)(P.ws + WS_E)};
        pg8::gemm_phase(ldsl, g, S, E);
    } SEAM(3);
    if (IN(4)) { phase4(P, lds); } SEAM(4);
    if (IN(5)) {
        { pg8::Gemm g{(const bf16_t*)(P.ws + WS_D), (const bf16_t*)(P.ws + WS_S5M2), 512, 512, 512};
          pg8::S5Order<8> S; S.init(G, cidx);
          EpiY E{(const bf16_t*)(P.ws + WS_D), P.ssm_d, (bf16_t*)(P.ws + WS_A) + (size_t)MLAT * 512};
          pg8::gemm_phase(ldsl, g, S, E); }
        { pg8::Gemm g{(const bf16_t*)(P.ws + WS_A), (const bf16_t*)(P.ws + WS_WBA), AW, AW, AW};
          pg8::StaticOrder S; S.init(MLAT, DM, G, cidx);
          EpiBranch<0> E{(const bf16_t*)(P.ws + WS_F), (bf16_t*)(P.ws + WS_C)};
          pg8::gemm_phase<EpiBranch<0>, pg8::StaticOrder, true, true>(ldsl, g, S, E); }
    } SEAM(5);
    if (IN(6)) {
        pg8::Gemm g{(const bf16_t*)(P.ws + WS_A) + (size_t)MLAT * 512, (const bf16_t*)(P.ws + WS_WGLU), SW, SW, SW};
        pg8::StaticOrder S; S.init(MLAT, 2 * SW, G, cidx);
        EpiGLU E{(bf16_t*)(P.ws + WS_B), SW};
        pg8::gemm_phase<EpiGLU, pg8::StaticOrder, true, true>(ldsl, g, S, E);
    } SEAM(6);
    if (IN(7)) {
        pg8::Gemm g{(const bf16_t*)(P.ws + WS_B), (const bf16_t*)(P.ws + WS_WBS), SW, SW, SW};
        pg8::StaticOrder S; S.init(MLAT, DM, G, cidx);
        EpiBranch<1> E{(const bf16_t*)(P.ws + WS_F) + 1024, (bf16_t*)(P.ws + WS_C)};
        pg8::gemm_phase<EpiBranch<1>, pg8::StaticOrder, true, true>(ldsl, g, S, E);
    } SEAM(7);
    if (IN(8)) {
        pg8::Gemm g{(const bf16_t*)(P.ws + WS_C), (const bf16_t*)(P.ws + WS_WOUT), DM, DM, DM};
        pg8::StaticOrder S; S.init(MLAT, DM, G, cidx);
        EpiWout E{P.x, mod, P.ffn_g, (bf16_t*)(P.ws + WS_F), (bf16_t*)(P.ws + WS_E), (float*)(P.ws + WS_SSP1)};
        pg8::gemm_phase<EpiWout, pg8::StaticOrder, true, true>(ldsl, g, S, E);
    } SEAM(8);
    if (IN(9)) {
        pg8::Gemm g{(const bf16_t*)(P.ws + WS_E), (const bf16_t*)(P.ws + WS_WFI), DM, DM, DM};
        pg8::StaticOrder S; S.init(MLAT, 2 * FH, G, cidx);
        EpiFFNIn E{(const float*)(P.ws + WS_SSP1), (const float*)(P.ws + WS_BIAS2), (bf16_t*)(P.ws + WS_HID)};
        pg8::gemm_phase<EpiFFNIn, pg8::StaticOrder, true, true>(ldsl, g, S, E);
    } SEAM(9);
    if (IN(10)) {
        pg8::Gemm g{(const bf16_t*)(P.ws + WS_HID), (const bf16_t*)(P.ws + WS_WFO), FH, FH, FH};
        pg8::StaticOrder S; S.init(MLAT, DM, G, cidx);
        EpiFFNOut E{mod, (bf16_t*)(P.ws + WS_F), (float*)(P.ws + WS_SSP2)};
        pg8::gemm_phase<EpiFFNOut, pg8::StaticOrder, true, true>(ldsl, g, S, E);
    } SEAM(10);
    if (IN(11)) { phase_final(P); }
    (void)ws16;
#undef IN
#undef SEAM
}

extern "C" void kernel_launch(void* const* d_in, const int* in_sizes, int n_in, void* d_out, int out_size, void* d_ws, size_t ws_size, hipStream_t stream) {
    static int grid = 0;
    if (grid == 0) {
        int dev = 0, cus = 0, per_cu = 0;
        (void)hipGetDevice(&dev);
        (void)hipDeviceGetAttribute(&cus, hipDeviceAttributeMultiprocessorCount, dev);
        (void)hipFuncSetAttribute((const void*)fwd_kernel, hipFuncAttributeMaxDynamicSharedMemorySize, LDS_BYTES);
        (void)hipOccupancyMaxActiveBlocksPerMultiprocessor(&per_cu, (const void*)fwd_kernel, 512, LDS_BYTES);
        if (per_cu < 1) { fprintf(stderr, "kernel_launch: occupancy query says %d blocks per CU\n", per_cu); per_cu = 1; }
        grid = cus;
        if (ws_size < WS_END) fprintf(stderr, "kernel_launch: workspace too small: %zu < %zu\n", ws_size, (size_t)WS_END);
    }
    Params p{};
    const float** pp = (const float**)&p;
    for (int i = 0; i < 25; ++i) pp[i] = (const float*)d_in[i];
    p.out = (float*)d_out; p.ws = (unsigned char*)d_ws;
#if ONE_LAUNCH
    (void)hipMemsetAsync((unsigned char*)d_ws + WS_BAR, 0, 4096 + XCD_BAR_WORDS * 4, stream);
    p.ph_lo = 0; p.ph_hi = NPHASE;
    void* args[] = {&p};
    hipError_t e = hipLaunchCooperativeKernel((const void*)fwd_kernel, dim3(grid), dim3(512), args, LDS_BYTES, stream);
    if (e != hipSuccess) fprintf(stderr, "cooperative launch failed: %s (grid %d)\n", hipGetErrorString(e), grid);
#else
    for (int ph = 0; ph < NPHASE; ++ph) {
        p.ph_lo = ph; p.ph_hi = ph + 1;
        hipLaunchKernelGGL(fwd_kernel, dim3(grid), dim3(512), LDS_BYTES, stream, p);
    }
#endif
}
```

```cpp
#include <hip/hip_runtime.h>
#include <hip/hip_cooperative_groups.h>
#include <cstdio>
namespace cg = cooperative_groups;

#ifndef ONE_LAUNCH
#define ONE_LAUNCH 1
#endif

#define LAS __attribute__((address_space(3)))
typedef unsigned short bf16_t;
typedef short bf16x8 __attribute__((ext_vector_type(8)));
typedef float f32x4 __attribute__((ext_vector_type(4)));
typedef float f32x2 __attribute__((ext_vector_type(2)));
typedef unsigned u32x4 __attribute__((ext_vector_type(4)));
typedef unsigned u32x2 __attribute__((ext_vector_type(2)));

constexpr int NB = 8, SEQL = 4096, DM = 1024, LCTX = 256, NH = 8, HD = 64, AW = 512, SW = 512, NG = 32, NP = 64, HG = 16, FH = 2816, INC = 4096;
constexpr int MLAT = NB * SEQL;
constexpr int MCTX = NB * LCTX;
constexpr int MALL = MLAT + MCTX;
constexpr int XH_ROWS = 2304;
constexpr float NORM_EPS = 1e-6f;
constexpr float LOG2E = 1.4426950408889634f;

constexpr size_t MiB = (size_t)1 << 20;
constexpr size_t WS_MOD = 0;
constexpr size_t WS_ROPE = 256 * 1024;
constexpr size_t WS_LBT = WS_ROPE + 16 * 1024;
constexpr size_t WS_SS1 = 512 * 1024;
constexpr size_t WS_SS2 = 640 * 1024;
constexpr size_t WS_BIAS2 = 768 * 1024;
constexpr size_t WS_BAR = 1024 * 1024;
constexpr size_t WS_WIN = 2 * MiB;
constexpr size_t WS_WGLU = 10 * MiB;
constexpr size_t WS_WBA = 11 * MiB;
constexpr size_t WS_WBS = 12 * MiB;
constexpr size_t WS_WOUT = 13 * MiB;
constexpr size_t WS_WFI = 15 * MiB;
constexpr size_t WS_WFO = 26 * MiB;
constexpr size_t WS_S5W1 = 32 * MiB;
constexpr size_t WS_S5M2 = 36 * MiB;
constexpr size_t WS_A = 44 * MiB;
constexpr size_t WS_B = 112 * MiB;
constexpr size_t WS_C = 144 * MiB;
constexpr size_t WS_D = 212 * MiB;
constexpr size_t WS_F = 284 * MiB;
constexpr size_t WS_E = 412 * MiB;
constexpr size_t WS_SSP1 = 484 * MiB;
constexpr size_t WS_SSP2 = 486 * MiB;
constexpr size_t WS_END = 488 * MiB;
constexpr size_t WS_HID = WS_A;

typedef __bf16 bf16x2_t __attribute__((ext_vector_type(2)));
__device__ __forceinline__ unsigned cvt_pk_bf16(float lo, float hi) { f32x2 f = {lo, hi}; bf16x2_t v = __builtin_convertvector(f, bf16x2_t); return __builtin_bit_cast(unsigned, v); }
__device__ __forceinline__ bf16_t f2bf(float v) { return (bf16_t)(cvt_pk_bf16(v, 0.f) & 0xffffu); }
__device__ __forceinline__ float bf2f(unsigned short b) { return __uint_as_float(((unsigned)b) << 16); }
__device__ __forceinline__ float bflo(unsigned w) { return __uint_as_float(w << 16); }
__device__ __forceinline__ float bfhi(unsigned w) { return __uint_as_float(w & 0xffff0000u); }
__device__ __forceinline__ float xmax32(float x) { auto r = __builtin_amdgcn_permlane32_swap(__float_as_uint(x), __float_as_uint(x), false, false); return fmaxf(__uint_as_float(r[0]), __uint_as_float(r[1])); }
__device__ __forceinline__ float xmax16(float x) { auto r = __builtin_amdgcn_permlane16_swap(__float_as_uint(x), __float_as_uint(x), false, false); return fmaxf(__uint_as_float(r[0]), __uint_as_float(r[1])); }
__device__ __forceinline__ float xsum32(float x) { auto r = __builtin_amdgcn_permlane32_swap(__float_as_uint(x), __float_as_uint(x), false, false); return __uint_as_float(r[0]) + __uint_as_float(r[1]); }
__device__ __forceinline__ float xsum16(float x) { auto r = __builtin_amdgcn_permlane16_swap(__float_as_uint(x), __float_as_uint(x), false, false); return __uint_as_float(r[0]) + __uint_as_float(r[1]); }
__device__ __forceinline__ float fast_sigmoid(float x) { return __builtin_amdgcn_rcpf(1.0f + __builtin_amdgcn_exp2f(-x * LOG2E)); }

namespace pg8 {
constexpr int BM = 256, BK = 64, HALF = 128, HTB = HALF * BK * 2, STAGE_BYTES = 8 * HTB, NXCD = 8, WGM = 8;
__host__ __device__ __forceinline__ int lds_byte(int r, int c) { const int st = (r >> 4) * 2 + (c >> 5), rr = r & 15, cc = c & 31, ob = rr * 64 + cc * 2; return st * 1024 + (ob ^ (((ob >> 9) & 1) << 5)); }
__host__ __device__ __forceinline__ void stage_rc(int b, int& R, int& C) { const int st = b / 1024, sb = b % 1024, swz = sb ^ (((sb >> 9) & 1) << 5); R = (st >> 1) * 16 + swz / 64; C = (st & 1) * 32 + (swz % 64) / 2; }
__host__ __device__ __forceinline__ int perm32(int rho) { const int n = rho >> 4, i = rho & 15; return 8 * (i >> 2) + 4 * n + (i & 3); }

struct Unit { int pm, pn; };
struct Gemm { const bf16_t* A; const bf16_t* Bt; int lda, ldb, K; };

struct StaticOrder {
    int nM, nN, nwg, G, c;
    __device__ void init(int M, int N, int G_, int c_) { nM = M / BM; nN = N / BM; nwg = nM * nN; G = G_; c = c_; }
    __device__ bool map(long L, Unit& u) const {
        if (L >= nwg) return false;
        int wgid = (int)L; { const int q = nwg / NXCD, r = nwg % NXCD, xcd = wgid % NXCD, off = wgid / NXCD; wgid = (xcd < r ? xcd * (q + 1) : r * (q + 1) + (xcd - r) * q) + off; }
        const int nig = WGM * nN, gid = wgid / nig, fm = gid * WGM, gsz = (nM - fm) < WGM ? (nM - fm) : WGM;
        u.pm = fm + ((wgid % nig) % gsz); u.pn = (wgid % nig) / gsz; return true;
    }
    __device__ bool next(int i, Unit& u) const { return map((long)i * G + c, u); }
};
struct CtxOrder {
    int Gc, c;
    __device__ bool next(int i, Unit& u) const { const int j = i * Gc + c; if (j >= 48) return false; u.pm = 128 + j / 6; u.pn = 2 + j % 6; return true; }
};
template <int NT> struct S5Order {
    int G, c;
    __device__ void init(int G_, int c_) { G = G_; c = c_; }
    __device__ bool next(int i, Unit& u) const {
        const long L = (long)i * G + c; if (L >= 32 * NT) return false;
        const int g = (int)L / NT, t = (int)L % NT; u.pm = g * 9 + t; u.pn = g; return true;
    }
};

template <class Epi, class Sched, bool ALIGN_EPI = false, bool SP2 = false>
__device__ __forceinline__ void gemm_phase(LAS unsigned char* lds, const Gemm g, const Sched& S, const Epi& E) {
    const int tid = threadIdx.x, wid = __builtin_amdgcn_readfirstlane(tid >> 6), lane = tid & 63, wr = wid >> 2, wc = wid & 3, fr = lane & 15, fq = lane >> 4;
    const int K = g.K, nt = K / BK;
    unsigned voffA[2], voffB[2];
#pragma unroll
    for (int i = 0; i < 2; ++i) { int R, C; stage_rc(tid * 16 + i * 8192, R, C); const int Rb = Epi::PERM ? ((R & ~31) + perm32(R & 31)) : R;
        voffA[i] = (unsigned)(R * g.lda + C) * 2u; voffB[i] = (unsigned)(Rb * g.ldb + C) * 2u; }
    const size_t kstep = (size_t)(BK * 2);
    const size_t hstepA = (size_t)HALF * g.lda * 2, hstepB = (size_t)HALF * g.ldb * 2;
    const size_t tstepA = 2 * hstepA, tstepB = 2 * hstepB;
    const unsigned ldsw = (unsigned)wid * 1024u;
    const int aoff = lds_byte(wr * 64 + fr, fq * 8), boff = lds_byte(wc * 32 + fr, fq * 8);
#define PG8_SA(b, h) (((b) * 2 + (h)) * HTB)
#define PG8_SB(b, h) ((4 + (b) * 2 + (h)) * HTB)
#define PG8_STAGE(bufoff, gbase, voff) do { _Pragma("unroll") for (int _i = 0; _i < 2; ++_i) \
        __builtin_amdgcn_global_load_lds((const unsigned*)((const char*)(gbase) + (voff)[_i]), (LAS unsigned*)(lds + (bufoff) + ldsw + _i * 8192), 16, 0, 0); } while (0)
#define PG8_LDA(dst, b, h) do { _Pragma("unroll") for (int m = 0; m < 4; ++m) _Pragma("unroll") for (int k = 0; k < 2; ++k) dst[m][k] = *(const LAS bf16x8*)(lds + PG8_SA(b, h) + aoff + m * 2048 + k * 1024); } while (0)
#define PG8_LDB(dst, b, h) do { _Pragma("unroll") for (int n = 0; n < 2; ++n) _Pragma("unroll") for (int k = 0; k < 2; ++k) dst[n][k] = *(const LAS bf16x8*)(lds + PG8_SB(b, h) + boff + n * 2048 + k * 1024); } while (0)
#define PG8_MMA(ai, bj, At, Bt) do { __builtin_amdgcn_s_setprio(1); _Pragma("unroll") for (int m = 0; m < 4; ++m) _Pragma("unroll") for (int n = 0; n < 2; ++n) _Pragma("unroll") for (int k = 0; k < 2; ++k) \
        acc[ai][bj][m][n] = __builtin_amdgcn_mfma_f32_16x16x32_bf16(Bt[n][k], At[m][k], acc[ai][bj][m][n], 0, 0, 0); __builtin_amdgcn_s_setprio(0); } while (0)
#define PG8_WAIT_V(n) asm volatile("s_waitcnt vmcnt(" #n ")" ::: "memory")
#define PG8_WAIT_L(n) asm volatile("s_waitcnt lgkmcnt(" #n ")" ::: "memory")
#define PG8_BAR __builtin_amdgcn_s_barrier()
#define PG8_SCHED __builtin_amdgcn_sched_barrier(0)
    Unit cur, nxt; int ui = 0;
    if (!S.next(0, cur)) return;
    f32x4 acc[2][2][4][2];
#pragma unroll
    for (int a = 0; a < 2; ++a)
#pragma unroll
        for (int b = 0; b < 2; ++b)
#pragma unroll
            for (int m = 0; m < 4; ++m)
#pragma unroll
                for (int n = 0; n < 2; ++n) acc[a][b][m][n] = (f32x4){0.f, 0.f, 0.f, 0.f};
    bf16x8 At[4][2], B0[2][2], B1[2][2];
    const char* cA = (const char*)g.A + (size_t)cur.pm * tstepA; const char* cB = (const char*)g.Bt + (size_t)cur.pn * tstepB;
    if constexpr (SP2) {
        PG8_STAGE(PG8_SB(0, 0), cB, voffB); PG8_STAGE(PG8_SB(0, 1), cB + hstepB, voffB); PG8_STAGE(PG8_SA(0, 0), cA, voffA); PG8_STAGE(PG8_SA(0, 1), cA + hstepA, voffA);
        if (wr == 1) PG8_BAR;
        PG8_WAIT_V(2); PG8_BAR;
        PG8_STAGE(PG8_SB(1, 0), cB + kstep, voffB); PG8_STAGE(PG8_SA(1, 0), cA + kstep, voffA); PG8_STAGE(PG8_SB(1, 1), cB + hstepB + kstep, voffB);
        PG8_WAIT_V(6); PG8_BAR;
    } else {
        PG8_STAGE(PG8_SB(0, 0), cB, voffB); PG8_STAGE(PG8_SA(0, 0), cA, voffA); PG8_STAGE(PG8_SB(0, 1), cB + hstepB, voffB); PG8_STAGE(PG8_SA(0, 1), cA + hstepA, voffA);
        if (wr == 1) PG8_BAR;
        PG8_WAIT_V(4); PG8_BAR;
        PG8_STAGE(PG8_SB(1, 0), cB + kstep, voffB); PG8_STAGE(PG8_SA(1, 0), cA + kstep, voffA); PG8_STAGE(PG8_SB(1, 1), cB + hstepB + kstep, voffB);
        PG8_WAIT_V(6); PG8_BAR;
    }
    for (;;) {
        const bool has_next = S.next(ui + 1, nxt);
        const char* nA = has_next ? (const char*)g.A + (size_t)nxt.pm * tstepA : cA; const char* nB = has_next ? (const char*)g.Bt + (size_t)nxt.pn * tstepB : cB;
        for (int t = 0; t < nt; t += 2) {
            const bool last = (t == nt - 2);
            const char* a1 = cA + (size_t)(t + 1) * kstep;
            const char* a2 = last ? nA : cA + (size_t)(t + 2) * kstep; const char* b2 = last ? nB : cB + (size_t)(t + 2) * kstep;
            const char* a3 = a2 + kstep; const char* b3 = b2 + kstep;
            if constexpr (SP2) {
            PG8_LDB(B0, 0, 0); PG8_LDB(B1, 0, 1); PG8_SCHED; PG8_LDA(At, 0, 0); PG8_STAGE(PG8_SA(1, 1), a1 + hstepA, voffA);
            PG8_WAIT_V(8); PG8_WAIT_L(0); PG8_BAR; PG8_MMA(0, 0, At, B0); PG8_MMA(0, 1, At, B1); PG8_BAR; PG8_SCHED;
            PG8_LDA(At, 0, 1); PG8_STAGE(PG8_SB(0, 0), b2, voffB); PG8_STAGE(PG8_SB(0, 1), b2 + hstepB, voffB); PG8_STAGE(PG8_SA(0, 0), a2, voffA);
            PG8_WAIT_V(8); PG8_WAIT_L(0); PG8_BAR; PG8_MMA(1, 0, At, B0); PG8_MMA(1, 1, At, B1); PG8_BAR; PG8_SCHED;
            PG8_LDB(B0, 1, 0); PG8_LDB(B1, 1, 1); PG8_SCHED; PG8_LDA(At, 1, 0); PG8_STAGE(PG8_SA(0, 1), a2 + hstepA, voffA);
            PG8_WAIT_V(8); PG8_WAIT_L(0); PG8_BAR; PG8_MMA(0, 0, At, B0); PG8_MMA(0, 1, At, B1); PG8_BAR; PG8_SCHED;
            PG8_LDA(At, 1, 1); PG8_STAGE(PG8_SB(1, 0), b3, voffB); PG8_STAGE(PG8_SB(1, 1), b3 + hstepB, voffB); PG8_STAGE(PG8_SA(1, 0), a3, voffA);
            PG8_WAIT_V(8); PG8_WAIT_L(0); PG8_BAR; PG8_MMA(1, 0, At, B0); PG8_MMA(1, 1, At, B1); PG8_BAR; PG8_SCHED;
            } else {
            PG8_LDB(B0, 0, 0); PG8_SCHED; PG8_LDA(At, 0, 0); PG8_STAGE(PG8_SA(1, 1), a1 + hstepA, voffA);
            PG8_WAIT_L(8); PG8_BAR; PG8_WAIT_L(0); PG8_MMA(0, 0, At, B0); PG8_BAR; PG8_SCHED;
            PG8_LDB(B1, 0, 1); PG8_STAGE(PG8_SB(0, 0), b2, voffB);
            PG8_BAR; PG8_WAIT_L(0); PG8_MMA(0, 1, At, B1); PG8_BAR;
            PG8_LDA(At, 0, 1); PG8_STAGE(PG8_SA(0, 0), a2, voffA);
            PG8_BAR; PG8_WAIT_L(0); PG8_MMA(1, 0, At, B0); PG8_BAR; PG8_SCHED;
            PG8_STAGE(PG8_SB(0, 1), b2 + hstepB, voffB);
            PG8_WAIT_V(6); PG8_BAR; PG8_MMA(1, 1, At, B1); PG8_BAR;
            PG8_LDB(B0, 1, 0); PG8_SCHED; PG8_LDA(At, 1, 0); PG8_STAGE(PG8_SA(0, 1), a2 + hstepA, voffA);
            PG8_WAIT_L(8); PG8_BAR; PG8_WAIT_L(0); PG8_MMA(0, 0, At, B0); PG8_BAR; PG8_SCHED;
            PG8_LDB(B1, 1, 1); PG8_STAGE(PG8_SB(1, 0), b3, voffB);
            PG8_BAR; PG8_WAIT_L(0); PG8_MMA(0, 1, At, B1); PG8_BAR;
            PG8_LDA(At, 1, 1); PG8_STAGE(PG8_SA(1, 0), a3, voffA);
            PG8_BAR; PG8_WAIT_L(0); PG8_MMA(1, 0, At, B0); PG8_BAR; PG8_SCHED;
            PG8_STAGE(PG8_SB(1, 1), b3 + hstepB, voffB);
            PG8_WAIT_V(6); PG8_BAR; PG8_MMA(1, 1, At, B1); PG8_BAR;
                    }
        }
        if constexpr (ALIGN_EPI) { if (wr == 0) PG8_BAR; }
        E(acc, cur, wr, wc, fr, fq);
        if (!has_next) break;
#pragma unroll
        for (int a = 0; a < 2; ++a)
#pragma unroll
            for (int b = 0; b < 2; ++b)
#pragma unroll
                for (int m = 0; m < 4; ++m)
#pragma unroll
                    for (int n = 0; n < 2; ++n) acc[a][b][m][n] = (f32x4){0.f, 0.f, 0.f, 0.f};
        cur = nxt; cA = nA; cB = nB; ++ui;
        if constexpr (ALIGN_EPI) { if (wr == 1) PG8_BAR; }
    }
    PG8_WAIT_V(0);
    if constexpr (!ALIGN_EPI) { if (wr == 0) PG8_BAR; }
    PG8_BAR;
#undef PG8_SA
#undef PG8_SB
#undef PG8_STAGE
#undef PG8_LDA
#undef PG8_LDB
#undef PG8_MMA
#undef PG8_WAIT_V
#undef PG8_WAIT_L
#undef PG8_BAR
#undef PG8_SCHED
}
}
using pg8::Unit;

#define EPI_ROWS_BEGIN _Pragma("unroll") for (int ai = 0; ai < 2; ++ai) _Pragma("unroll") for (int m = 0; m < 4; ++m) {
#define EPI_ROWS_END }

struct EpiInProj {
    static constexpr bool PERM = true;
    bf16_t *q, *k, *vt, *vtc, *xh, *sig; const f32x2* rope;
    __device__ __forceinline__ void operator()(const f32x4 (&acc)[2][2][4][2], const Unit& u, int wr, int wc, int fr, int fq) const {
        const int pn = u.pn; const bool isctx = u.pm >= 128;
        const int kind = pn < 2 ? 0 : pn < 4 ? 1 : pn < 6 ? 2 : pn < 8 ? 3 : 4;
        EPI_ROWS_BEGIN
            const int r = u.pm * 256 + ai * 128 + wr * 64 + m * 16 + fr;
#pragma unroll
            for (int bj = 0; bj < 2; ++bj) {
                const int c = pn * 256 + bj * 128 + wc * 32 + 8 * fq;
                f32x4 v0 = acc[ai][bj][m][0], v1 = acc[ai][bj][m][1];
                if (kind <= 1) {
                    if (!isctx) {
                        const int t = r & 4095; const int pos = (wc & 1) ? (t & 63) : (t >> 6);
                        const f32x4* cs = (const f32x4*)(rope + pos * 16 + 8 * (fq & 1));
                        const f32x4 cs0 = cs[0], cs1 = cs[1], cs2 = cs[2], cs3 = cs[3];
                        const float sg = (fq >> 1) ? 1.0f : -1.0f;
                        f32x4 p0, p1;
#pragma unroll
                        for (int j = 0; j < 4; ++j) { p0[j] = __shfl_xor(v0[j], 32); p1[j] = __shfl_xor(v1[j], 32); }
                        v0[0] = v0[0] * cs0[0] + sg * p0[0] * cs0[1]; v0[1] = v0[1] * cs0[2] + sg * p0[1] * cs0[3];
                        v0[2] = v0[2] * cs1[0] + sg * p0[2] * cs1[1]; v0[3] = v0[3] * cs1[2] + sg * p0[3] * cs1[3];
                        v1[0] = v1[0] * cs2[0] + sg * p1[0] * cs2[1]; v1[1] = v1[1] * cs2[2] + sg * p1[1] * cs2[3];
                        v1[2] = v1[2] * cs3[0] + sg * p1[2] * cs3[1]; v1[3] = v1[3] * cs3[2] + sg * p1[3] * cs3[3];
                    }
                    u32x4 w; w.x = cvt_pk_bf16(v0[0], v0[1]); w.y = cvt_pk_bf16(v0[2], v0[3]); w.z = cvt_pk_bf16(v1[0], v1[1]); w.w = cvt_pk_bf16(v1[2], v1[3]);
                    bf16_t* dst = (kind == 0) ? (q + (size_t)r * 512 + c) : (k + (size_t)r * 512 + (c - 512));
                    *(u32x4*)dst = w;
                } else if (kind == 2) {
                    const int cv = c - 1024, h = cv >> 6, d0 = cv & 63;
                    bf16_t* dst;
                    if (!isctx) { const int b = r >> 12, t = r & 4095; dst = vt + ((size_t)((b * 8 + h) * 512 + (t >> 3))) * 512 + d0 * 8 + (t & 7); }
                    else { const int rc = r - MLAT, b = rc >> 8, mm = rc & 255; dst = vtc + ((size_t)((b * 8 + h) * 32 + (mm >> 3))) * 512 + d0 * 8 + (mm & 7); }
#pragma unroll
                    for (int j = 0; j < 4; ++j) { dst[8 * j] = f2bf(v0[j]); dst[8 * (4 + j)] = f2bf(v1[j]); }
                } else if (kind == 3) {
                    const int cu = c - 1536, g = cu >> 4, h0 = cu & 15;
                    size_t row; int col;
                    if (!isctx) { const int b = r >> 12, t = r & 4095; row = (size_t)g * XH_ROWS + b * 256 + (t >> 4); col = (t & 15) * 16 + h0; }
                    else { const int rc = r - MLAT, b = rc >> 8, mm = rc & 255; row = (size_t)g * XH_ROWS + 2048 + b * 16 + (mm >> 4); col = (mm & 15) * 16 + h0; }
                    u32x4 w; w.x = cvt_pk_bf16(v0[0], v0[1]); w.y = cvt_pk_bf16(v0[2], v0[3]); w.z = cvt_pk_bf16(v1[0], v1[1]); w.w = cvt_pk_bf16(v1[2], v1[3]);
                    *(u32x4*)(xh + row * 512 + col) = w;
                } else {
                    u32x4 w; w.x = cvt_pk_bf16(fast_sigmoid(v0[0]), fast_sigmoid(v0[1])); w.y = cvt_pk_bf16(fast_sigmoid(v0[2]), fast_sigmoid(v0[3]));
                    w.z = cvt_pk_bf16(fast_sigmoid(v1[0]), fast_sigmoid(v1[1])); w.w = cvt_pk_bf16(fast_sigmoid(v1[2]), fast_sigmoid(v1[3]));
                    *(u32x4*)(sig + (size_t)r * 2048 + (c - 2048)) = w;
                }
            }
        EPI_ROWS_END
    }
};

struct EpiE {
    static constexpr bool PERM = false;
    float* E;
    __device__ __forceinline__ void operator()(const f32x4 (&acc)[2][2][4][2], const Unit& u, int wr, int wc, int fr, int fq) const {
        EPI_ROWS_BEGIN
            const int r = u.pm * 256 + ai * 128 + wr * 64 + m * 16 + fr;
            float* rowp = E + (size_t)r * 256 + wc * 32 + 4 * fq;
#pragma unroll
            for (int bj = 0; bj < 2; ++bj)
#pragma unroll
                for (int n = 0; n < 2; ++n) *(f32x4*)(rowp + bj * 128 + n * 16) = acc[ai][bj][m][n];
        EPI_ROWS_END
    }
};

__device__ __forceinline__ float gelu_tanh(float x) {
    const float z = 1.5957691216057308f * (x + 0.044715f * x * x * x);
    return x * fast_sigmoid(z);
}

struct EpiY {
    static constexpr bool PERM = true;
    const bf16_t* xh; const float* dsk; bf16_t* y;
    __device__ __forceinline__ void operator()(const f32x4 (&acc)[2][2][4][2], const Unit& u, int wr, int wc, int fr, int fq) const {
        const int g = u.pn, it = u.pm - g * 9;
        const int rr0 = wr * 64 + fr, c00 = wc * 32 + 8 * fq, h0 = c00 & 15;
        u32x4 uu[2][4][2];
#pragma unroll
        for (int ai = 0; ai < 2; ++ai)
#pragma unroll
            for (int m = 0; m < 4; ++m)
#pragma unroll
                for (int bj = 0; bj < 2; ++bj) uu[ai][m][bj] = *(const u32x4*)(xh + ((size_t)u.pm * 256 + rr0 + ai * 128 + m * 16) * 512 + c00 + bj * 128);
        const f32x4 d0 = *(const f32x4*)(dsk + g * 16 + h0), d1 = *(const f32x4*)(dsk + g * 16 + h0 + 4);
        EPI_ROWS_BEGIN
            const int rr = rr0 + ai * 128 + m * 16;
            const int idx = it * 256 + rr, b = idx >> 8, cch = idx & 255;
#pragma unroll
            for (int bj = 0; bj < 2; ++bj) {
                const int t = (c00 + bj * 128) >> 4;
                const u32x4 w4 = uu[ai][m][bj];
                const f32x4 v0 = acc[ai][bj][m][0], v1 = acc[ai][bj][m][1];
                float o[8];
                o[0] = v0[0] + d0[0] * bflo(w4.x); o[1] = v0[1] + d0[1] * bfhi(w4.x); o[2] = v0[2] + d0[2] * bflo(w4.y); o[3] = v0[3] + d0[3] * bfhi(w4.y);
                o[4] = v1[0] + d1[0] * bflo(w4.z); o[5] = v1[1] + d1[1] * bfhi(w4.z); o[6] = v1[2] + d1[2] * bflo(w4.w); o[7] = v1[3] + d1[3] * bfhi(w4.w);
#pragma unroll
                for (int j = 0; j < 8; ++j) o[j] = gelu_tanh(o[j]);
                u32x4 w; w.x = cvt_pk_bf16(o[0], o[1]); w.y = cvt_pk_bf16(o[2], o[3]); w.z = cvt_pk_bf16(o[4], o[5]); w.w = cvt_pk_bf16(o[6], o[7]);
                *(u32x4*)(y + ((size_t)(b * 4096 + cch * 16 + t)) * 512 + g * 16 + h0) = w;
            }
        EPI_ROWS_END
    }
};

struct EpiGLU {
    static constexpr bool PERM = true;
    bf16_t* o; int ld;
    __device__ __forceinline__ void operator()(const f32x4 (&acc)[2][2][4][2], const Unit& u, int wr, int wc, int fr, int fq) const {
        EPI_ROWS_BEGIN
            const int r = u.pm * 256 + ai * 128 + wr * 64 + m * 16 + fr;
            const int oc = u.pn * 128 + wc * 32 + 8 * fq;
            const f32x4 a0 = acc[ai][0][m][0], a1 = acc[ai][0][m][1], g0 = acc[ai][1][m][0], g1 = acc[ai][1][m][1];
            u32x4 w; w.x = cvt_pk_bf16(a0[0] * fast_sigmoid(g0[0]), a0[1] * fast_sigmoid(g0[1])); w.y = cvt_pk_bf16(a0[2] * fast_sigmoid(g0[2]), a0[3] * fast_sigmoid(g0[3]));
            w.z = cvt_pk_bf16(a1[0] * fast_sigmoid(g1[0]), a1[1] * fast_sigmoid(g1[1])); w.w = cvt_pk_bf16(a1[2] * fast_sigmoid(g1[2]), a1[3] * fast_sigmoid(g1[3]));
            *(u32x4*)(o + (size_t)r * ld + oc) = w;
        EPI_ROWS_END
    }
};

template <int SECOND> struct EpiBranch {
    static constexpr bool PERM = true;
    const bf16_t* sig; bf16_t* mb;
    __device__ __forceinline__ void operator()(const f32x4 (&acc)[2][2][4][2], const Unit& u, int wr, int wc, int fr, int fq) const {
        const int r0 = u.pm * 256 + wr * 64 + fr, c00 = u.pn * 256 + wc * 32 + 8 * fq;
#pragma unroll
        for (int ai = 0; ai < 2; ++ai) {
            u32x4 sg[4][2], pv[4][2];
#pragma unroll
            for (int m = 0; m < 4; ++m)
#pragma unroll
                for (int bj = 0; bj < 2; ++bj) { const size_t r = (size_t)(r0 + ai * 128 + m * 16);
                    sg[m][bj] = *(const u32x4*)(sig + r * 2048 + c00 + bj * 128);
                    if (SECOND) pv[m][bj] = *(const u32x4*)(mb + r * 1024 + c00 + bj * 128); }
#pragma unroll
            for (int m = 0; m < 4; ++m)
#pragma unroll
                for (int bj = 0; bj < 2; ++bj) {
                    const u32x4 sv = sg[m][bj];
                    const f32x4 v0 = acc[ai][bj][m][0], v1 = acc[ai][bj][m][1];
                    float o[8];
                    o[0] = v0[0] * bflo(sv.x); o[1] = v0[1] * bfhi(sv.x); o[2] = v0[2] * bflo(sv.y); o[3] = v0[3] * bfhi(sv.y);
                    o[4] = v1[0] * bflo(sv.z); o[5] = v1[1] * bfhi(sv.z); o[6] = v1[2] * bflo(sv.w); o[7] = v1[3] * bfhi(sv.w);
                    if (SECOND) { const u32x4 pp = pv[m][bj];
                        o[0] += bflo(pp.x); o[1] += bfhi(pp.x); o[2] += bflo(pp.y); o[3] += bfhi(pp.y); o[4] += bflo(pp.z); o[5] += bfhi(pp.z); o[6] += bflo(pp.w); o[7] += bfhi(pp.w); }
                    u32x4 w; w.x = cvt_pk_bf16(o[0], o[1]); w.y = cvt_pk_bf16(o[2], o[3]); w.z = cvt_pk_bf16(o[4], o[5]); w.w = cvt_pk_bf16(o[6], o[7]);
                    *(u32x4*)(mb + (size_t)(r0 + ai * 128 + m * 16) * 1024 + c00 + bj * 128) = w;
                }
        }
    }
};

struct EpiWout {
    static constexpr bool PERM = true;
    const float* x; const float* mod; const float* gffn; bf16_t* out; bf16_t* ap; float* ss;
    __device__ __forceinline__ void operator()(const f32x4 (&acc)[2][2][4][2], const Unit& u, int wr, int wc, int fr, int fq) const {
        const int b = u.pm >> 4;
        const float* g1 = mod + b * 6144 + 2 * 1024; const float* sc2 = mod + b * 6144 + 4 * 1024;
        const int r0 = u.pm * 256 + wr * 64 + fr, c00 = u.pn * 256 + wc * 32 + 8 * fq;
        f32x4 gv[2][2], gs[2][2];
#pragma unroll
        for (int bj = 0; bj < 2; ++bj)
#pragma unroll
            for (int n = 0; n < 2; ++n) { const int c = c00 + bj * 128 + 4 * n; gv[bj][n] = *(const f32x4*)(g1 + c); gs[bj][n] = *(const f32x4*)(gffn + c) * (*(const f32x4*)(sc2 + c) + 1.0f); }
#pragma unroll
        for (int ai = 0; ai < 2; ++ai)
#pragma unroll
        for (int mh = 0; mh < 2; ++mh) {
            f32x4 xv[2][2][2];
#pragma unroll
            for (int m2 = 0; m2 < 2; ++m2)
#pragma unroll
                for (int bj = 0; bj < 2; ++bj)
#pragma unroll
                    for (int n = 0; n < 2; ++n) xv[m2][bj][n] = *(const f32x4*)(x + (size_t)(r0 + ai * 128 + (mh * 2 + m2) * 16) * 1024 + c00 + bj * 128 + 4 * n);
#pragma unroll
            for (int m2 = 0; m2 < 2; ++m2) { const int m = mh * 2 + m2;
                const size_t r = (size_t)(r0 + ai * 128 + m * 16);
                float sq = 0.f;
#pragma unroll
                for (int bj = 0; bj < 2; ++bj)
#pragma unroll
                    for (int n = 0; n < 2; ++n) {
                        const int c = c00 + bj * 128 + 4 * n;
                        const f32x4 h = xv[m2][bj][n] + gv[bj][n] * acc[ai][bj][m][n];
                        { u32x2 hw; hw.x = cvt_pk_bf16(h[0], h[1]); hw.y = cvt_pk_bf16(h[2], h[3]); *(u32x2*)(out + r * 1024 + c) = hw; }
                        sq += h[0] * h[0] + h[1] * h[1] + h[2] * h[2] + h[3] * h[3];
                        const f32x4 a = h * gs[bj][n];
                        u32x2 w; w.x = cvt_pk_bf16(a[0], a[1]); w.y = cvt_pk_bf16(a[2], a[3]);
                        *(u32x2*)(ap + r * 1024 + c) = w;
                    }
                sq = xsum16(xsum32(sq));
                if (fq == 0) ss[r * 16 + u.pn * 4 + wc] = sq;
            }
        }
    }
};

struct EpiFFNIn {
    static constexpr bool PERM = true;
    const float* ss; const float* bias2; bf16_t* hid;
    __device__ __forceinline__ void operator()(const f32x4 (&acc)[2][2][4][2], const Unit& u, int wr, int wc, int fr, int fq) const {
        const int b = u.pm >> 4;
        const int r0 = u.pm * 256 + wr * 64 + fr, c00 = u.pn * 256 + wc * 32 + 8 * fq, oc = u.pn * 128 + wc * 32 + 8 * fq;
        f32x4 sp[8], ba[2], bb[2];
#pragma unroll
        for (int i = 0; i < 8; ++i) sp[i] = *(const f32x4*)(ss + (size_t)(r0 + (i >> 2) * 128 + (i & 3) * 16) * 16 + 4 * fq);
#pragma unroll
        for (int n = 0; n < 2; ++n) { ba[n] = *(const f32x4*)(bias2 + b * 5632 + c00 + 4 * n); bb[n] = *(const f32x4*)(bias2 + b * 5632 + c00 + 128 + 4 * n); }
        float rstd[8];
#pragma unroll
        for (int i = 0; i < 8; ++i) { float t = (sp[i][0] + sp[i][1]) + (sp[i][2] + sp[i][3]); t = xsum16(xsum32(t)); rstd[i] = 1.0f / sqrtf(t * (1.0f / 1024.0f) + NORM_EPS); }
        EPI_ROWS_BEGIN
            const int r = r0 + ai * 128 + m * 16;
            u32x4 w;
#pragma unroll
            for (int n = 0; n < 2; ++n) {
                const f32x4 va = acc[ai][0][m][n] * rstd[ai * 4 + m] + ba[n], vb = acc[ai][1][m][n] * rstd[ai * 4 + m] + bb[n];
                const unsigned lo = cvt_pk_bf16(va[0] * fast_sigmoid(va[0]) * vb[0], va[1] * fast_sigmoid(va[1]) * vb[1]);
                const unsigned hi = cvt_pk_bf16(va[2] * fast_sigmoid(va[2]) * vb[2], va[3] * fast_sigmoid(va[3]) * vb[3]);
                if (n == 0) { w.x = lo; w.y = hi; } else { w.z = lo; w.w = hi; }
            }
            *(u32x4*)(hid + (size_t)r * FH + oc) = w;
        EPI_ROWS_END
    }
};

struct EpiFFNOut {
    static constexpr bool PERM = true;
    const float* mod; bf16_t* out; float* ss;
    __device__ __forceinline__ void operator()(const f32x4 (&acc)[2][2][4][2], const Unit& u, int wr, int wc, int fr, int fq) const {
        const int b = u.pm >> 4;
        const float* g2 = mod + b * 6144 + 5 * 1024;
        const int r0 = u.pm * 256 + wr * 64 + fr, c00 = u.pn * 256 + wc * 32 + 8 * fq;
        f32x4 gv[2][2];
#pragma unroll
        for (int bj = 0; bj < 2; ++bj)
#pragma unroll
            for (int n = 0; n < 2; ++n) gv[bj][n] = *(const f32x4*)(g2 + c00 + bj * 128 + 4 * n);
#pragma unroll
        for (int ai = 0; ai < 2; ++ai) {
            u32x2 hv[4][2][2];
#pragma unroll
            for (int m = 0; m < 4; ++m)
#pragma unroll
                for (int bj = 0; bj < 2; ++bj)
#pragma unroll
                    for (int n = 0; n < 2; ++n) hv[m][bj][n] = *(const u32x2*)(out + (size_t)(r0 + ai * 128 + m * 16) * 1024 + c00 + bj * 128 + 4 * n);
#pragma unroll
            for (int m = 0; m < 4; ++m) {
                const size_t r = (size_t)(r0 + ai * 128 + m * 16);
                float sq = 0.f;
#pragma unroll
                for (int bj = 0; bj < 2; ++bj)
#pragma unroll
                    for (int n = 0; n < 2; ++n) {
                        const u32x2 hq = hv[m][bj][n];
                        const f32x4 h = (f32x4){bflo(hq.x), bfhi(hq.x), bflo(hq.y), bfhi(hq.y)} + gv[bj][n] * acc[ai][bj][m][n];
                        { u32x2 hw; hw.x = cvt_pk_bf16(h[0], h[1]); hw.y = cvt_pk_bf16(h[2], h[3]); *(u32x2*)(out + r * 1024 + c00 + bj * 128 + 4 * n) = hw; }
                        sq += h[0] * h[0] + h[1] * h[1] + h[2] * h[2] + h[3] * h[3];
                    }
                sq = xsum16(xsum32(sq));
                if (fq == 0) ss[r * 16 + u.pn * 4 + wc] = sq;
            }
        }
    }
};

struct Params {
    const float *x, *c, *ctx, *c_ctx, *w_mod, *b_mod, *attn_g, *ffn_g, *w_in, *rpb, *lam_re, *lam_im, *log_dt, *b_re, *b_im, *c_re, *c_im, *ssm_d,
        *w_glu, *w_ba, *w_bs, *w_out, *w_fi, *w_fo, *final_g;
    float* out; unsigned char* ws;
    int ph_lo, ph_hi;
};

__device__ __forceinline__ void sincos_d(double a, float& s, float& c) {
    const double inv2pi = 0.15915494309189533577, twopi = 6.283185307179586477;
    double x = a - twopi * __builtin_rint(a * inv2pi);
    const double x2 = x * x;
    double ts = 1.0, tc = 1.0;
    ts = 1.0; tc = 1.0;
#pragma unroll
    for (int k = 13; k >= 1; --k) { ts = 1.0 - x2 * ts * (1.0 / (double)((2 * k) * (2 * k + 1))); tc = 1.0 - x2 * tc * (1.0 / (double)((2 * k - 1) * (2 * k))); }
    s = (float)(x * ts); c = (float)tc;
}

__device__ void tr_strip(const float* __restrict__ src, int N, int K, int ks, int nt, bf16_t* __restrict__ dst, int half, unsigned short* T) {
    const int tid = threadIdx.x;
    { const int n = tid & 63, kb = tid >> 6; float v[32];
      const float* sp = src + (size_t)(ks * 256 + kb) * N + nt * 64 + n;
#pragma unroll
      for (int i = 0; i < 32; ++i) v[i] = sp[(size_t)(8 * i) * N];
#pragma unroll
      for (int i = 0; i < 32; ++i) T[(kb + 8 * i) * 66 + n] = f2bf(v[i]); }
    __syncthreads();
    { const int nn = tid >> 3, kc = (tid & 7) * 8; const int ncol = nt * 64 + nn;
      int drow = ncol;
      if (half) drow = ncol < half ? ((ncol >> 7) * 256 + (ncol & 127)) : (((ncol - half) >> 7) * 256 + 128 + ((ncol - half) & 127));
#pragma unroll
      for (int q = 0; q < 4; ++q) { const int kk = q * 64 + kc; unsigned short v[8];
#pragma unroll
        for (int j = 0; j < 8; ++j) v[j] = T[(kk + j) * 66 + nn];
        u32x4 w; w.x = v[0] | ((unsigned)v[1] << 16); w.y = v[2] | ((unsigned)v[3] << 16); w.z = v[4] | ((unsigned)v[5] << 16); w.w = v[6] | ((unsigned)v[7] << 16);
        *(u32x4*)(dst + (size_t)drow * K + ks * 256 + kk) = w; } }
    __syncthreads();
}

template <int NR>
__device__ void gemv_tile(const float* __restrict__ W, int N, int n0, const float* A_lds, float* red, float (&res)[2], int (&ridx)[2]) {
    const int tid = threadIdx.x, col = tid & 63, ks = tid >> 6;
    float acc[NR];
#pragma unroll
    for (int r = 0; r < NR; ++r) acc[r] = 0.f;
    const float* wp = W + (size_t)(ks * 128) * N + n0 + col;
#pragma unroll 16
    for (int k = 0; k < 128; ++k) { const float w = wp[(size_t)k * N];
#pragma unroll
        for (int r = 0; r < NR; ++r) acc[r] += A_lds[r * 1024 + ks * 128 + k] * w; }
#pragma unroll
    for (int r = 0; r < NR; ++r) red[(ks * NR + r) * 64 + col] = acc[r];
    __syncthreads();
#pragma unroll
    for (int e = 0; e < 2; ++e) { const int idx = tid + e * 512; ridx[e] = idx; float s = 0.f;
        if (idx < NR * 64) { const int r = idx >> 6, cc = idx & 63;
#pragma unroll
            for (int k8 = 0; k8 < 8; ++k8) s += red[(k8 * NR + r) * 64 + cc]; }
        res[e] = s; }
    __syncthreads();
}

__device__ void s5_build(const Params& P, int g, float* L) {
    float* lbp = L; float* Bb = L + 4352; float* Cc = L + 8448; float* Kt = L + 12544;
    const int tid = threadIdx.x;
#pragma unroll 5
    for (int idx = tid; idx < 2 * 17 * 64; idx += 512) {
        const int p = idx & 63, d = (idx >> 6) % 17, dir = idx / (17 * 64);
        const float dt = expf(P.log_dt[dir * 32 + g]);
        const float lr = P.lam_re[(dir * 32 + g) * 64 + p], li = P.lam_im[(dir * 32 + g) * 64 + p];
        const float mag = expf(lr * dt * (float)d); float s, c; sincos_d((double)li * (double)dt * (double)d, s, c);
        lbp[((dir * 17 + d) * 64 + p) * 2] = mag * c; lbp[((dir * 17 + d) * 64 + p) * 2 + 1] = mag * s;
    }
#pragma unroll 4
    for (int idx = tid; idx < 2 * 16 * 64; idx += 512) {
        const int p = idx & 63, h = (idx >> 6) & 15, dir = idx >> 10;
        Cc[((dir * 64 + p) * 16 + h) * 2] = P.c_re[((dir * 32 + g) * 16 + h) * 64 + p]; Cc[((dir * 64 + p) * 16 + h) * 2 + 1] = P.c_im[((dir * 32 + g) * 16 + h) * 64 + p];
    }
    __syncthreads();
#pragma unroll 4
    for (int idx = tid; idx < 2 * 64 * 16; idx += 512) {
        const int h = idx & 15, p = (idx >> 4) & 63, dir = idx >> 10;
        const float lr = P.lam_re[(dir * 32 + g) * 64 + p], li = P.lam_im[(dir * 32 + g) * 64 + p];
        const float nr = lbp[((dir * 17 + 1) * 64 + p) * 2] - 1.0f, ni = lbp[((dir * 17 + 1) * 64 + p) * 2 + 1];
        const float den = lr * lr + li * li;
        const float fre = (nr * lr + ni * li) / den, fim = (ni * lr - nr * li) / den;
        const float br = P.b_re[((dir * 32 + g) * 64 + p) * 16 + h], bi = P.b_im[((dir * 32 + g) * 64 + p) * 16 + h];
        Bb[((dir * 64 + p) * 16 + h) * 2] = fre * br - fim * bi; Bb[((dir * 64 + p) * 16 + h) * 2 + 1] = fre * bi + fim * br;
    }
    if (tid < 128) { const int p = tid & 63, dir = tid >> 6;
        ((f32x2*)(P.ws + WS_LBT))[(dir * 32 + g) * 64 + p] = (f32x2){lbp[((dir * 17 + 16) * 64 + p) * 2], lbp[((dir * 17 + 16) * 64 + p) * 2 + 1]}; }
    __syncthreads();
    { const int h = tid & 15, d = (tid >> 4) & 15, dir = tid >> 8;
      float ak[16];
#pragma unroll
      for (int j = 0; j < 16; ++j) ak[j] = 0.f;
      for (int p = 0; p < 64; ++p) {
          const f32x2 cc = *(const f32x2*)(Cc + ((dir * 64 + p) * 16 + h) * 2), zz = *(const f32x2*)(lbp + ((dir * 17 + d) * 64 + p) * 2);
          const float czr = cc.x * zz.x - cc.y * zz.y, czi = cc.x * zz.y + cc.y * zz.x;
          const f32x4* bp = (const f32x4*)(Bb + (dir * 64 + p) * 32);
#pragma unroll
          for (int j4 = 0; j4 < 8; ++j4) { const f32x4 bq = bp[j4]; ak[2 * j4] += czr * bq[0] - czi * bq[1]; ak[2 * j4 + 1] += czr * bq[2] - czi * bq[3]; }
      }
#pragma unroll
      for (int j = 0; j < 16; ++j) Kt[((dir * 16 + d) * 16 + h) * 16 + j] = ak[j]; }
    __syncthreads();
    bf16_t* W1 = (bf16_t*)(P.ws + WS_S5W1) + (size_t)g * 256 * 256;
    for (int v = tid; v < 256 * 32; v += 512) {
        const int n = v >> 5, k0 = (v & 31) * 8, dir = n >> 7, p = (n >> 1) & 63, ri = n & 1, s = k0 >> 4, h0 = k0 & 15;
        const int d = dir ? s : 15 - s;
        const float zr = lbp[((dir * 17 + d) * 64 + p) * 2], zi = lbp[((dir * 17 + d) * 64 + p) * 2 + 1];
        float o[8];
#pragma unroll
        for (int j = 0; j < 8; ++j) { const float br = Bb[((dir * 64 + p) * 16 + h0 + j) * 2], bi = Bb[((dir * 64 + p) * 16 + h0 + j) * 2 + 1];
            o[j] = ri ? (zr * bi + zi * br) : (zr * br - zi * bi); }
        u32x4 w; w.x = cvt_pk_bf16(o[0], o[1]); w.y = cvt_pk_bf16(o[2], o[3]); w.z = cvt_pk_bf16(o[4], o[5]); w.w = cvt_pk_bf16(o[6], o[7]);
        *(u32x4*)(W1 + (size_t)n * 256 + k0) = w;
    }
    bf16_t* M2 = (bf16_t*)(P.ws + WS_S5M2) + (size_t)g * 256 * 512;
    for (int v = tid; v < 256 * 64; v += 512) {
        const int n = v & 255, k0 = (v >> 8) * 8, t = n >> 4, h = n & 15;
        float o[8];
        if (k0 < 256) { const int s = k0 >> 4, h0 = k0 & 15;
#pragma unroll
            for (int j = 0; j < 8; ++j) { float a = 0.f;
                if (s <= t) a += Kt[((0 * 16 + (t - s)) * 16 + h) * 16 + h0 + j];
                if (s >= t) a += Kt[((1 * 16 + (s - t)) * 16 + h) * 16 + h0 + j];
                o[j] = a; }
        } else { const int dir = (k0 - 256) >> 7, kk = (k0 - 256) & 127, d = dir ? 16 - t : t + 1;
#pragma unroll
            for (int j = 0; j < 8; ++j) { const int p = (kk + j) >> 1, ri = (kk + j) & 1;
                const float cr = Cc[((dir * 64 + p) * 16 + h) * 2], ci = Cc[((dir * 64 + p) * 16 + h) * 2 + 1];
                const float zr = lbp[((dir * 17 + d) * 64 + p) * 2], zi = lbp[((dir * 17 + d) * 64 + p) * 2 + 1];
                o[j] = ri ? -(cr * zi + ci * zr) : (cr * zr - ci * zi); }
        }
        u32x4 w; w.x = cvt_pk_bf16(o[0], o[1]); w.y = cvt_pk_bf16(o[2], o[3]); w.z = cvt_pk_bf16(o[4], o[5]); w.w = cvt_pk_bf16(o[6], o[7]);
        *(u32x4*)(M2 + (size_t)n * 512 + k0) = w;
    }
    __syncthreads();
}

__device__ __forceinline__ void norm_rows2(const Params& P, int rowa, int rowb, int lane) {
    const float* mod = (const float*)(P.ws + WS_MOD);
    bf16_t* nb = (bf16_t*)(P.ws + WS_A);
    const int rows[2] = {rowa, rowb};
    f32x4 v[2][4];
#pragma unroll
    for (int q = 0; q < 2; ++q) { const int row = rows[q];
        const float* src = row < MLAT ? P.x + (size_t)row * 1024 : P.ctx + (size_t)(row - MLAT) * 1024;
#pragma unroll
        for (int i = 0; i < 4; ++i) v[q][i] = __builtin_nontemporal_load((const f32x4*)(src + 4 * lane + 256 * i)); }
#pragma unroll
    for (int q = 0; q < 2; ++q) { const int row = rows[q];
        const int mr = row < MLAT ? (row >> 12) : 8;
        const float* sh = mod + mr * 6144; const float* sc = sh + 1024;
        float ss = 0.f;
#pragma unroll
        for (int i = 0; i < 4; ++i) ss += v[q][i][0] * v[q][i][0] + v[q][i][1] * v[q][i][1] + v[q][i][2] * v[q][i][2] + v[q][i][3] * v[q][i][3];
#pragma unroll
        for (int o = 32; o >= 1; o >>= 1) ss += __shfl_xor(ss, o);
        const float rstd = 1.0f / sqrtf(ss * (1.0f / 1024.0f) + NORM_EPS);
#pragma unroll
        for (int i = 0; i < 4; ++i) { const int c = 4 * lane + 256 * i;
            const f32x4 gv = *(const f32x4*)(P.attn_g + c), sv = *(const f32x4*)(sc + c), hv = *(const f32x4*)(sh + c);
            const f32x4 o = v[q][i] * rstd * gv * (sv + 1.0f) + hv;
            u32x2 w; w.x = cvt_pk_bf16(o[0], o[1]); w.y = cvt_pk_bf16(o[2], o[3]);
            *(u32x2*)(nb + (size_t)row * 1024 + c) = w; } }
}

struct TrDesc { const float* src; bf16_t* dst; int N, K, half, nstrip_k, nitems; };

__device__ void phase0(const Params& P, unsigned char* lds) {
    const int tid = threadIdx.x;
    float* Lf = (float*)lds;
    int* qslot = (int*)(lds + 100 * 1024);
    unsigned* queue = (unsigned*)(P.ws + WS_BAR) + 64;
    TrDesc td[7] = {
        {P.w_in, (bf16_t*)(P.ws + WS_WIN), INC, DM, 0, DM / 256, (INC / 64) * (DM / 256)},
        {P.w_glu, (bf16_t*)(P.ws + WS_WGLU), 2 * SW, SW, SW, SW / 256, ((2 * SW) / 64) * (SW / 256)},
        {P.w_ba, (bf16_t*)(P.ws + WS_WBA), DM, AW, 0, AW / 256, (DM / 64) * (AW / 256)},
        {P.w_bs, (bf16_t*)(P.ws + WS_WBS), DM, SW, 0, SW / 256, (DM / 64) * (SW / 256)},
        {P.w_out, (bf16_t*)(P.ws + WS_WOUT), DM, DM, 0, DM / 256, (DM / 64) * (DM / 256)},
        {P.w_fi, (bf16_t*)(P.ws + WS_WFI), 2 * FH, DM, FH, DM / 256, ((2 * FH) / 64) * (DM / 256)},
        {P.w_fo, (bf16_t*)(P.ws + WS_WFO), DM, FH, 0, FH / 256, (DM / 64) * (FH / 256)}};
    int ntr = 0;
#pragma unroll
    for (int i = 0; i < 7; ++i) ntr += td[i].nitems;
    const int NI = 32 + 96 + 1 + ntr + 128;
    unsigned* modcnt = (unsigned*)(P.ws + WS_BAR) + 128;
    for (;;) {
        __syncthreads();
        if (tid == 0) *qslot = (int)atomicAdd(queue, 1u);
        __syncthreads();
        const int it = *qslot;
        if (it >= NI) break;
        if (it >= 32 && it < 64) {
            s5_build(P, it - 32, Lf);
        } else if (it < 128) {
            const int mt = it < 32 ? it : it - 32;
            for (int idx = tid; idx < 9 * 1024; idx += 512) { const float v = idx < 8192 ? P.c[idx] : P.c_ctx[idx - 8192]; Lf[idx] = v * fast_sigmoid(v); }
            __syncthreads();
            float res[2]; int ridx[2];
            gemv_tile<9>(P.w_mod, 6 * DM, mt * 64, Lf, Lf + 9 * 1024, res, ridx);
#pragma unroll
            for (int e = 0; e < 2; ++e) if (ridx[e] < 9 * 64) { const int r = ridx[e] >> 6, cc = ridx[e] & 63; ((float*)(P.ws + WS_MOD))[r * 6144 + mt * 64 + cc] = res[e] + P.b_mod[mt * 64 + cc]; }
            if (mt < 32) {
                asm volatile("s_waitcnt vmcnt(0)" ::: "memory"); __syncthreads();
                if (tid == 0) { __builtin_amdgcn_fence(__ATOMIC_RELEASE, "agent"); asm volatile("s_waitcnt vmcnt(0)" ::: "memory");
                    __hip_atomic_fetch_add(modcnt, 1u, __ATOMIC_RELAXED, __HIP_MEMORY_SCOPE_AGENT); }
            }
        } else if (it == 128) {
            for (int idx = tid; idx < 1024; idx += 512) { const int pos = idx >> 4, i = idx & 15;
                const float invf = expf(-(float)i * (1.0f / 16.0f) * 9.210340371976184f);
                float sn, cs; sincos_d((double)((float)pos * invf), sn, cs);
                ((f32x2*)(P.ws + WS_ROPE))[idx] = (f32x2){cs, sn}; }
        } else if (it >= 129 + ntr) {
            if (tid == 0) { unsigned spins = 0;
                while (__hip_atomic_load(modcnt, __ATOMIC_RELAXED, __HIP_MEMORY_SCOPE_AGENT) < 32u) { __builtin_amdgcn_s_sleep(4); if (++spins > (1u << 22)) break; }
                __builtin_amdgcn_fence(__ATOMIC_ACQUIRE, "agent"); asm volatile("s_waitcnt vmcnt(0)" ::: "memory"); }
            __syncthreads();
            const int base = MLAT + (it - 129 - ntr) * 16, wave = tid >> 6;
            norm_rows2(P, base + wave, base + 8 + wave, tid & 63);
        } else {
            int j = it - 129, w = 0;
#pragma unroll
            for (int i = 0; i < 6; ++i) if (w == i && j >= td[i].nitems) { j -= td[i].nitems; w = i + 1; }
            const float* src = td[0].src; bf16_t* dst = td[0].dst; int N = td[0].N, K = td[0].K, half = td[0].half, nk = td[0].nstrip_k;
#pragma unroll
            for (int i = 1; i < 7; ++i) if (w == i) { src = td[i].src; dst = td[i].dst; N = td[i].N; K = td[i].K; half = td[i].half; nk = td[i].nstrip_k; }
            tr_strip(src, N, K, j % nk, j / nk, dst, half, (unsigned short*)lds);
        }
    }
}

__device__ void phase1(const Params& P, unsigned char* lds) {
    const int tid = threadIdx.x, G = gridDim.x, lane = tid & 63, wave = tid >> 6;
    float* Lf = (float*)lds;
    const float* mod = (const float*)(P.ws + WS_MOD);
    for (int it = blockIdx.x; it < 88; it += G) {
        for (int idx = tid; idx < 8 * 1024; idx += 512) Lf[idx] = mod[(idx >> 10) * 6144 + 3 * 1024 + (idx & 1023)];
        __syncthreads();
        float res[2]; int ridx[2];
        gemv_tile<8>(P.w_fi, 2 * FH, it * 64, Lf, Lf + 8 * 1024, res, ridx);
        if (ridx[0] < 8 * 64) { const int r = ridx[0] >> 6, ncol = it * 64 + (ridx[0] & 63);
            const int drow = ncol < FH ? ((ncol >> 7) * 256 + (ncol & 127)) : (((ncol - FH) >> 7) * 256 + 128 + ((ncol - FH) & 127));
            ((float*)(P.ws + WS_BIAS2))[r * 5632 + drow] = res[0]; }
    }
    const int NBR = G > 96 ? G - 48 : G;
    for (int row0 = blockIdx.x * 8 + wave; row0 < MLAT; row0 += NBR * 16) {
        const int rb = row0 + NBR * 8;
        norm_rows2(P, row0, rb < MLAT ? rb : row0, lane);
    }
}

__device__ __forceinline__ void scan_task(const Params& P, int task, int lane) {
    const int g = task >> 4, dir = (task >> 3) & 1, b = task & 7, p = lane;
    const f32x2 lb = ((const f32x2*)(P.ws + WS_LBT))[(dir * 32 + g) * 64 + p];
    const float* __restrict__ Eg = (const float*)(P.ws + WS_E) + (size_t)g * XH_ROWS * 256 + dir * 128 + 2 * p;
    unsigned* __restrict__ xh = (unsigned*)((bf16_t*)(P.ws + WS_D) + (size_t)g * XH_ROWS * 512 + 256 + dir * 128 + 2 * p);
    float hr = 0.f, hi = 0.f;
    f32x2 e[16];
#pragma unroll
    for (int i = 0; i < 16; ++i) { const int cc = dir ? 15 - i : i; e[i] = *(const f32x2*)(Eg + (size_t)(2048 + b * 16 + cc) * 256); }
#pragma unroll
    for (int i = 0; i < 16; ++i) { const float nr = lb.x * hr - lb.y * hi + e[i].x, ni = lb.x * hi + lb.y * hr + e[i].y; hr = nr; hi = ni; }
    f32x2 en[32];
#pragma unroll
    for (int i = 0; i < 32; ++i) { const int c = dir ? 255 - i : i; en[i] = *(const f32x2*)(Eg + (size_t)(b * 256 + c) * 256); }
#pragma unroll 1
    for (int blk = 0; blk < 8; ++blk) {
        f32x2 ec[32];
#pragma unroll
        for (int i = 0; i < 32; ++i) ec[i] = en[i];
        if (blk < 7) {
#pragma unroll
            for (int i = 0; i < 32; ++i) { const int ci = (blk + 1) * 32 + i; const int c = dir ? 255 - ci : ci; en[i] = *(const f32x2*)(Eg + (size_t)(b * 256 + c) * 256); }
        }
#pragma unroll
        for (int i = 0; i < 32; ++i) { const int ci = blk * 32 + i; const int c = dir ? 255 - ci : ci;
            xh[(size_t)(b * 256 + c) * 256] = cvt_pk_bf16(hr, hi);
            const float nr = lb.x * hr - lb.y * hi + ec[i].x, ni = lb.x * hi + lb.y * hr + ec[i].y; hr = nr; hi = ni; }
    }
}

constexpr int ATT_LK = 0, ATT_LV = 256 * 144, ATT_LB = ATT_LV + 32768, ATT_LC = ATT_LB + 2048;

template <bool LOC, int NT>
__device__ __forceinline__ void att_sm_pv(f32x4 (&s)[NT], const bf16x8 (&vv)[NT / 2][4], f32x4 (&o)[5], float& mrun,
                                          const float* rpbl, const int (&dcl)[8], unsigned inw, int dr) {
    const float SC = 0.125f * LOG2E;
    float mnew;
    if (LOC) {
        float mx = -1e30f;
#pragma unroll
        for (int tile = 0; tile < NT; ++tile)
#pragma unroll
            for (int j = 0; j < 4; ++j) { const int jj = 4 * (tile & 1) + j;
                const float bv = rpbl[dr * 31 + dcl[jj]];
                const float tv = __builtin_fmaf(s[tile][j], SC, bv);
                const float v = ((inw >> jj) & 1u) ? tv : -1e30f;
                s[tile][j] = v; mx = fmaxf(mx, v); }
        mx = xmax16(xmax32(mx));
        mnew = fmaxf(mrun, mx);
#pragma unroll
        for (int tile = 0; tile < NT; ++tile)
#pragma unroll
            for (int j = 0; j < 4; ++j) s[tile][j] = __builtin_amdgcn_exp2f(s[tile][j] - mnew);
    } else {
        float mx = -1e30f;
#pragma unroll
        for (int tile = 0; tile < NT; ++tile)
#pragma unroll
            for (int j = 0; j < 4; ++j) mx = fmaxf(mx, s[tile][j]);
        mx = xmax16(xmax32(mx)) * SC;
        mnew = fmaxf(mrun, mx);
#pragma unroll
        for (int tile = 0; tile < NT; ++tile)
#pragma unroll
            for (int j = 0; j < 4; ++j) s[tile][j] = __builtin_amdgcn_exp2f(__builtin_fmaf(s[tile][j], SC, -mnew));
    }
    if (__builtin_amdgcn_ballot_w64(mnew > mrun) != 0ull) {
        const float alpha = __builtin_amdgcn_exp2f(mrun - mnew);
#pragma unroll
        for (int d = 0; d < 5; ++d) o[d] *= alpha;
    }
    mrun = mnew;
    const bf16x8 ones = {(short)0x3F80, (short)0x3F80, (short)0x3F80, (short)0x3F80, (short)0x3F80, (short)0x3F80, (short)0x3F80, (short)0x3F80};
#pragma unroll
    for (int kb2 = 0; kb2 < NT / 2; ++kb2) {
        u32x4 pw; pw.x = cvt_pk_bf16(s[2 * kb2][0], s[2 * kb2][1]); pw.y = cvt_pk_bf16(s[2 * kb2][2], s[2 * kb2][3]);
        pw.z = cvt_pk_bf16(s[2 * kb2 + 1][0], s[2 * kb2 + 1][1]); pw.w = cvt_pk_bf16(s[2 * kb2 + 1][2], s[2 * kb2 + 1][3]);
        bf16x8 pb; __builtin_memcpy(&pb, &pw, 16);
#pragma unroll
        for (int d = 0; d < 4; ++d) o[d] = __builtin_amdgcn_mfma_f32_16x16x32_bf16(vv[kb2][d], pb, o[d], 0, 0, 0);
        o[4] = __builtin_amdgcn_mfma_f32_16x16x32_bf16(ones, pb, o[4], 0, 0, 0);
    }
}

__device__ __forceinline__ void attn_task2(const Params& P, int b, int h, int rA, int cb, int lane, const float* rpbl, const LAS unsigned char* ldsl) {
    const int n = lane & 15, g4 = lane >> 4;
    const bf16_t* qb = (const bf16_t*)(P.ws + WS_B);
    const bf16_t* kb = (const bf16_t*)(P.ws + WS_C);
    const bf16_t* vt = kb + (size_t)MALL * 512;
    bf16_t* ab = (bf16_t*)(P.ws + WS_A);
    const int tqA = rA * 64 + cb * 16 + n;
    const bf16_t* qp = qb + ((size_t)(b * 4096 + tqA)) * 512 + h * 64 + 8 * g4;
    const bf16x8 qA0 = *(const bf16x8*)qp, qA1 = *(const bf16x8*)(qp + 32), qB0 = *(const bf16x8*)(qp + 64 * 512), qB1 = *(const bf16x8*)(qp + 64 * 512 + 32);
    const int rsA = min(max(rA - 4, 0), 56), rsB = min(max(rA - 3, 0), 56), bs = min(max(16 * cb - 8, 0), 32);
    const int qcol = 16 * cb + n, cst = min(max(qcol - 8, 0), 48);
    int dcl[8]; unsigned inw = 0;
#pragma unroll
    for (int jj = 0; jj < 8; ++jj) { const int kcol = bs + 8 * g4 + jj; if (kcol >= cst && kcol < cst + 16) inw |= 1u << jj; dcl[jj] = min(max(kcol - qcol, -15), 15) + 15; }
    f32x4 oA[5], oB[5];
#pragma unroll
    for (int d = 0; d < 5; ++d) { oA[d] = (f32x4){0.f, 0.f, 0.f, 0.f}; oB[d] = (f32x4){0.f, 0.f, 0.f, 0.f}; }
    float mA = -1e30f, mB = -1e30f;
    const int kx = 8 * (n >> 2) + (n & 3);
    const bf16_t* kloc = kb + ((size_t)b * 4096 + bs + kx) * 512 + h * 64 + 8 * g4;
    const bf16_t* vloc = vt + ((size_t)(b * 8 + h) * 512 + bs / 8 + g4) * 512 + n * 8;
    bf16x8 kc[2][2], kn[2][2], vc[1][4], vn[1][4];
#define ATT_LOADROW(kd, vd, row) do { _Pragma("unroll") for (int tile = 0; tile < 2; ++tile) { \
        const bf16_t* kp_ = kloc + (size_t)(row) * (64 * 512) + tile * (4 * 512); kd[tile][0] = *(const bf16x8*)kp_; kd[tile][1] = *(const bf16x8*)(kp_ + 32); } \
        _Pragma("unroll") for (int d = 0; d < 4; ++d) vd[0][d] = *(const bf16x8*)(vloc + (size_t)(row) * (8 * 512) + d * 128); } while (0)
    ATT_LOADROW(kc, vc, rsA);
    const LAS unsigned char* lk = ldsl + ATT_LK + kx * 144 + g4 * 16;
    const LAS unsigned char* lv = ldsl + ATT_LV + (g4 * 64 + n) * 16;
#pragma unroll 1
    for (int step = 0; step < 4; ++step) {
        f32x4 sA[4], sB[4]; bf16x8 vl[2][4];
#pragma unroll
        for (int tile = 0; tile < 4; ++tile) {
            const LAS unsigned char* kp = lk + (2 * step + (tile >> 1)) * (32 * 144) + (tile & 1) * (4 * 144);
            const bf16x8 k0 = *(const LAS bf16x8*)kp, k1 = *(const LAS bf16x8*)(kp + 64);
            sA[tile] = __builtin_amdgcn_mfma_f32_16x16x32_bf16(k0, qA0, (f32x4){0.f, 0.f, 0.f, 0.f}, 0, 0, 0);
            sA[tile] = __builtin_amdgcn_mfma_f32_16x16x32_bf16(k1, qA1, sA[tile], 0, 0, 0);
            sB[tile] = __builtin_amdgcn_mfma_f32_16x16x32_bf16(k0, qB0, (f32x4){0.f, 0.f, 0.f, 0.f}, 0, 0, 0);
            sB[tile] = __builtin_amdgcn_mfma_f32_16x16x32_bf16(k1, qB1, sB[tile], 0, 0, 0);
        }
#pragma unroll
        for (int kb2 = 0; kb2 < 2; ++kb2)
#pragma unroll
            for (int d = 0; d < 4; ++d) vl[kb2][d] = *(const LAS bf16x8*)(lv + (2 * step + kb2) * 4096 + d * 256);
        att_sm_pv<false, 4>(sA, vl, oA, mA, rpbl, dcl, inw, 0);
        att_sm_pv<false, 4>(sB, vl, oB, mB, rpbl, dcl, inw, 0);
    }
    const int klast = rsB + 7;
#pragma unroll 1
    for (int k = rsA; k <= klast; ++k) {
        if (k < klast) ATT_LOADROW(kn, vn, k + 1);
        if (k < rsA + 8) {
            f32x4 s[2];
#pragma unroll
            for (int tile = 0; tile < 2; ++tile) {
                s[tile] = __builtin_amdgcn_mfma_f32_16x16x32_bf16(kc[tile][0], qA0, (f32x4){0.f, 0.f, 0.f, 0.f}, 0, 0, 0);
                s[tile] = __builtin_amdgcn_mfma_f32_16x16x32_bf16(kc[tile][1], qA1, s[tile], 0, 0, 0); }
            att_sm_pv<true, 2>(s, vc, oA, mA, rpbl, dcl, inw, k - rA + 7);
        }
        if (k >= rsB) {
            f32x4 s[2];
#pragma unroll
            for (int tile = 0; tile < 2; ++tile) {
                s[tile] = __builtin_amdgcn_mfma_f32_16x16x32_bf16(kc[tile][0], qB0, (f32x4){0.f, 0.f, 0.f, 0.f}, 0, 0, 0);
                s[tile] = __builtin_amdgcn_mfma_f32_16x16x32_bf16(kc[tile][1], qB1, s[tile], 0, 0, 0); }
            att_sm_pv<true, 2>(s, vc, oB, mB, rpbl, dcl, inw, k - (rA + 1) + 7);
        }
#pragma unroll
        for (int tile = 0; tile < 2; ++tile) { kc[tile][0] = kn[tile][0]; kc[tile][1] = kn[tile][1]; }
#pragma unroll
        for (int d = 0; d < 4; ++d) vc[0][d] = vn[0][d];
    }
#undef ATT_LOADROW
    const float invA = 1.0f / oA[4][0], invB = 1.0f / oB[4][0];
    bf16_t* op = ab + ((size_t)(b * 4096 + tqA)) * 512 + h * 64 + 4 * g4;
#pragma unroll
    for (int d = 0; d < 4; ++d) {
        u32x2 w; w.x = cvt_pk_bf16(oA[d][0] * invA, oA[d][1] * invA); w.y = cvt_pk_bf16(oA[d][2] * invA, oA[d][3] * invA); *(u32x2*)(op + 16 * d) = w;
        u32x2 w2; w2.x = cvt_pk_bf16(oB[d][0] * invB, oB[d][1] * invB); w2.y = cvt_pk_bf16(oB[d][2] * invB, oB[d][3] * invB); *(u32x2*)(op + 64 * 512 + 16 * d) = w2; }
}

__device__ void phase4(const Params& P, unsigned char* lds) {
    const int tid = threadIdx.x, G = gridDim.x, lane = tid & 63, wave = tid >> 6;
    const LAS unsigned char* ldsl = (const LAS unsigned char*)lds;
    float* rpbl = (float*)(lds + ATT_LB);
    int* ctr = (int*)(lds + ATT_LC);
    if (wave < 2) for (int task = blockIdx.x * 2 + wave; task < 512; task += G * 2) scan_task(P, task, lane);
    const bf16_t* kb = (const bf16_t*)(P.ws + WS_C);
    const bf16_t* vtc = kb + (size_t)MALL * 512 + (size_t)MLAT * 512;
    for (int bt = blockIdx.x; bt < 256; bt += G) {
        const int xcd = bt & 7, j = bt >> 3, pair = xcd * 8 + (j >> 2), quarter = j & 3, b = pair >> 3, h = pair & 7;
        __syncthreads();
        for (int idx = tid; idx < 15 * 31; idx += 512) rpbl[idx] = P.rpb[h * 465 + idx] * LOG2E;
        if (tid == 0) *ctr = 0;
#pragma unroll 1
        for (int i = 0; i < 4; ++i) { const int e = tid + 512 * i, key = e >> 3, ch = e & 7;
            const u32x4 kvv = *(const u32x4*)(kb + ((size_t)MLAT + b * 256 + key) * 512 + h * 64 + ch * 8);
            *(u32x4*)(lds + ATT_LK + key * 144 + ch * 16) = kvv;
            const u32x4 vvv = *(const u32x4*)(vtc + (size_t)(b * 8 + h) * 32 * 512 + (size_t)e * 8);
            *(u32x4*)(lds + ATT_LV + e * 16) = vvv; }
        __syncthreads();
        for (;;) {
            int t = 0; if (lane == 0) t = atomicAdd(ctr, 1);
            t = __shfl(t, 0);
            if (t >= 32) break;
            attn_task2(P, b, h, quarter * 16 + 2 * (t >> 2), t & 3, lane, rpbl, ldsl);
        }
    }
}

__device__ void phase_final(const Params& P) {
    const int tid = threadIdx.x, G = gridDim.x, lane = tid & 63, wave = tid >> 6;
    const float* ss = (const float*)(P.ws + WS_SSP2);
    const bf16_t* hb = (const bf16_t*)(P.ws + WS_F);
    for (int row0 = blockIdx.x * 8 + wave; row0 < MLAT; row0 += G * 16) {
        const int rows[2] = {row0, row0 + G * 8};
        u32x2 hq[2][4]; f32x4 sp[2];
#pragma unroll
        for (int q = 0; q < 2; ++q) { const int row = rows[q] < MLAT ? rows[q] : row0;
            sp[q] = *(const f32x4*)(ss + (size_t)row * 16 + 4 * (lane & 3));
#pragma unroll
            for (int i = 0; i < 4; ++i) hq[q][i] = __builtin_nontemporal_load((const u32x2*)(hb + (size_t)row * 1024 + 4 * lane + 256 * i)); }
#pragma unroll
        for (int q = 0; q < 2; ++q) { const int row = rows[q]; if (row >= MLAT) continue;
            float t = (sp[q][0] + sp[q][1]) + (sp[q][2] + sp[q][3]); t += __shfl_xor(t, 1); t += __shfl_xor(t, 2);
            const float rstd = 1.0f / sqrtf(t * (1.0f / 1024.0f) + NORM_EPS);
#pragma unroll
            for (int i = 0; i < 4; ++i) { const int c = 4 * lane + 256 * i;
                const f32x4 v = (f32x4){bflo(hq[q][i].x), bfhi(hq[q][i].x), bflo(hq[q][i].y), bfhi(hq[q][i].y)}, gv = *(const f32x4*)(P.final_g + c);
                __builtin_nontemporal_store(v * rstd * gv, (f32x4*)(P.out + (size_t)row * 1024 + c)); } }
    }
}

#define XB_TMO      128
#define XB_XCNT(j)  (256  + 64 * (j))
#define XB_XSUB(j)  (1280 + 64 * (j))
#define XB_XGEN(j)  (2304 + 64 * (j))
#define XB_TOP      3328
#define XB_TOPGEN   3392
#define XCD_BAR_WORDS 3456
#define XB_SPIN_CAP (1u << 18)

__device__ __forceinline__ unsigned xb_ld(unsigned* p)              { return __hip_atomic_load(p, __ATOMIC_RELAXED, __HIP_MEMORY_SCOPE_AGENT); }
__device__ __forceinline__ unsigned xb_add(unsigned* p, unsigned v) { return __hip_atomic_fetch_add(p, v, __ATOMIC_RELAXED, __HIP_MEMORY_SCOPE_AGENT); }
__device__ __forceinline__ unsigned xb_xcc_id() { return (unsigned)__builtin_amdgcn_s_getreg((3 << 11) | 20) & 0xFu; }
#define XB_SPIN(cond, bar) do { unsigned _sp = 0; while (cond) { __builtin_amdgcn_s_sleep(1); \
    if ((++_sp & 255u) == 0u) { if (xb_ld(&(bar)[XB_TMO])) break; if (_sp > XB_SPIN_CAP) { atomicAdd(&(bar)[XB_TMO], 1u); break; } } } } while (0)

struct XcdBarrier {
    unsigned* bar; unsigned x;
    volatile LAS unsigned* st;
};

__device__ __forceinline__ XcdBarrier xcd_barrier_post(unsigned* bar, volatile LAS unsigned* st) {
    XcdBarrier b; b.bar = bar; b.x = xb_xcc_id(); b.st = st;
    if (threadIdx.x == 0) (void)xb_add(&bar[XB_XCNT(b.x)], 1u);
    return b;
}
__device__ __forceinline__ void xcd_barrier_complete(unsigned* bar, unsigned x, unsigned& nloc, unsigned& nx) {
    const unsigned G = gridDim.x * gridDim.y * gridDim.z;
    unsigned sum, cnt, mine, sp = 0u;
    for (;;) {
        sum = 0u; cnt = 0u; mine = 0u;
#pragma unroll
        for (unsigned j = 0; j < 16; ++j) { const unsigned c = xb_ld(&bar[XB_XCNT(j)]); sum += c; cnt += (c > 0u) ? 1u : 0u; mine = (j == x) ? c : mine; }
        if (sum == G) break;
        __builtin_amdgcn_s_sleep(1);
        if ((++sp & 255u) == 0u) { if (xb_ld(&bar[XB_TMO])) break; if (sp > XB_SPIN_CAP) { atomicAdd(&bar[XB_TMO], 1u); break; } }
    }
    nloc = mine > 0u ? mine : 1u; nx = cnt > 0u ? cnt : 1u;
}

__device__ __forceinline__ void xcd_barrier(const XcdBarrier& b) {
    asm volatile("s_waitcnt vmcnt(0)" ::: "memory");
    __syncthreads();
    if (threadIdx.x == 0) {
        unsigned* bar = b.bar;
        __builtin_amdgcn_s_waitcnt(0);
        unsigned nloc = b.st[0], nx = b.st[1];
        if (nloc == 0u) { xcd_barrier_complete(bar, b.x, nloc, nx); b.st[0] = nloc; b.st[1] = nx; }
        const unsigned old = xb_add(&bar[XB_XSUB(b.x)], 1u);
        const unsigned gen = old / nloc;
        if (old + 1u == (gen + 1u) * nloc) {
            __builtin_amdgcn_fence(__ATOMIC_RELEASE, "agent");
            asm volatile("s_waitcnt vmcnt(0)" ::: "memory");
            const unsigned og = xb_add(&bar[XB_TOP], 1u);
            const unsigned tg = og / nx;
            if (og + 1u == (tg + 1u) * nx) xb_add(&bar[XB_TOPGEN], 1u);
            else XB_SPIN(xb_ld(&bar[XB_TOPGEN]) == tg, bar);
            __builtin_amdgcn_fence(__ATOMIC_ACQUIRE, "agent");
            xb_add(&bar[XB_XGEN(b.x)], 1u);
            asm volatile("s_waitcnt vmcnt(0)" ::: "memory");
        } else {
            XB_SPIN(xb_ld(&bar[XB_XGEN(b.x)]) == gen, bar);
            __builtin_amdgcn_fence(__ATOMIC_ACQUIRE, "agent");
            asm volatile("s_waitcnt vmcnt(0)" ::: "memory");
        }
    }
    __syncthreads();
}

constexpr int LDS_BYTES = pg8::STAGE_BYTES + 16;
constexpr int NPHASE = 12;

__global__ void __launch_bounds__(512, 2) fwd_kernel(Params P) {
    extern __shared__ __attribute__((aligned(16))) unsigned char lds[];
    LAS unsigned char* ldsl = (LAS unsigned char*)lds;
    const int G = gridDim.x, cidx = blockIdx.x;
    const int lo = P.ph_lo, hi = P.ph_hi;
#define IN(k) (lo <= (k) && (k) < hi)
    unsigned* barw = (unsigned*)(P.ws + WS_BAR);
    (void)barw;
    volatile LAS unsigned* xst = (volatile LAS unsigned*)(ldsl + pg8::STAGE_BYTES);
    if (threadIdx.x < 4) xst[threadIdx.x] = 0u;
    __syncthreads();
    const XcdBarrier xbar = xcd_barrier_post((unsigned*)(P.ws + WS_BAR + 4096), xst);
#define SEAM(k) do { if (IN(k) && IN((k) + 1)) { if ((k) == 0) cg::this_grid().sync(); else { xcd_barrier(xbar); } } } while (0)
    bf16_t* ws16 = (bf16_t*)P.ws;
    const float* mod = (const float*)(P.ws + WS_MOD);
    if (IN(0)) { phase0(P, lds); } SEAM(0);
    if (IN(1)) {
        const bool split = G > 96, gemm_wg = !split || cidx >= G - 48;
        if (!split || !gemm_wg) phase1(P, lds);
        if (gemm_wg) {
            if (!split) __syncthreads();
            pg8::Gemm g{(const bf16_t*)(P.ws + WS_A), (const bf16_t*)(P.ws + WS_WIN), DM, DM, DM};
            pg8::CtxOrder S{split ? 48 : G, split ? cidx - (G - 48) : cidx};
            bf16_t* kb = (bf16_t*)(P.ws + WS_C);
            EpiInProj E{(bf16_t*)(P.ws + WS_B), kb, kb + (size_t)MALL * 512, kb + (size_t)MALL * 512 + (size_t)MLAT * 512, (bf16_t*)(P.ws + WS_D), (bf16_t*)(P.ws + WS_F), (const f32x2*)(P.ws + WS_ROPE)};
            pg8::gemm_phase(ldsl, g, S, E);
        }
    } SEAM(1);
    if (IN(2)) {
        pg8::Gemm g{(const bf16_t*)(P.ws + WS_A), (const bf16_t*)(P.ws + WS_WIN), DM, DM, DM};
        pg8::StaticOrder S; S.init(MLAT, INC, G, cidx);
        bf16_t* kb = (bf16_t*)(P.ws + WS_C);
        EpiInProj E{(bf16_t*)(P.ws + WS_B), kb, kb + (size_t)MALL * 512, kb + (size_t)MALL * 512 + (size_t)MLAT * 512, (bf16_t*)(P.ws + WS_D), (bf16_t*)(P.ws + WS_F), (const f32x2*)(P.ws + WS_ROPE)};
        pg8::gemm_phase<EpiInProj, pg8::StaticOrder, true, true>(ldsl, g, S, E);
    } SEAM(2);
    if (IN(3)) {
        pg8::Gemm g{(const bf16_t*)(P.ws + WS_D), (const bf16_t*)(P.ws + WS_S5W1), 512, 256, 256};
        pg8::S5Order<9> S; S.init(G, cidx);
        EpiE E{(float*)(P.ws + WS_E)};
        pg8::gemm_phase(ldsl, g, S, E);
    } SEAM(3);
    if (IN(4)) { phase4(P, lds); } SEAM(4);
    if (IN(5)) {
        { pg8::Gemm g{(const bf16_t*)(P.ws + WS_D), (const bf16_t*)(P.ws + WS_S5M2), 512, 512, 512};
          pg8::S5Order<8> S; S.init(G, cidx);
          EpiY E{(const bf16_t*)(P.ws + WS_D), P.ssm_d, (bf16_t*)(P.ws + WS_A) + (size_t)MLAT * 512};
          pg8::gemm_phase(ldsl, g, S, E); }
        { pg8::Gemm g{(const bf16_t*)(P.ws + WS_A), (const bf16_t*)(P.ws + WS_WBA), AW, AW, AW};
          pg8::StaticOrder S; S.init(MLAT, DM, G, cidx);
          EpiBranch<0> E{(const bf16_t*)(P.ws + WS_F), (bf16_t*)(P.ws + WS_C)};
          pg8::gemm_phase<EpiBranch<0>, pg8::StaticOrder, true, true>(ldsl, g, S, E); }
    } SEAM(5);
    if (IN(6)) {
        pg8::Gemm g{(const bf16_t*)(P.ws + WS_A) + (size_t)MLAT * 512, (const bf16_t*)(P.ws + WS_WGLU), SW, SW, SW};
        pg8::StaticOrder S; S.init(MLAT, 2 * SW, G, cidx);
        EpiGLU E{(bf16_t*)(P.ws + WS_B), SW};
        pg8::gemm_phase<EpiGLU, pg8::StaticOrder, true, true>(ldsl, g, S, E);
    } SEAM(6);
    if (IN(7)) {
        pg8::Gemm g{(const bf16_t*)(P.ws + WS_B), (const bf16_t*)(P.ws + WS_WBS), SW, SW, SW};
        pg8::StaticOrder S; S.init(MLAT, DM, G, cidx);
        EpiBranch<1> E{(const bf16_t*)(P.ws + WS_F) + 1024, (bf16_t*)(P.ws + WS_C)};
        pg8::gemm_phase<EpiBranch<1>, pg8::StaticOrder, true, true>(ldsl, g, S, E);
    } SEAM(7);
    if (IN(8)) {
        pg8::Gemm g{(const bf16_t*)(P.ws + WS_C), (const bf16_t*)(P.ws + WS_WOUT), DM, DM, DM};
        pg8::StaticOrder S; S.init(MLAT, DM, G, cidx);
        EpiWout E{P.x, mod, P.ffn_g, (bf16_t*)(P.ws + WS_F), (bf16_t*)(P.ws + WS_E), (float*)(P.ws + WS_SSP1)};
        pg8::gemm_phase<EpiWout, pg8::StaticOrder, true, true>(ldsl, g, S, E);
    } SEAM(8);
    if (IN(9)) {
        pg8::Gemm g{(const bf16_t*)(P.ws + WS_E), (const bf16_t*)(P.ws + WS_WFI), DM, DM, DM};
        pg8::StaticOrder S; S.init(MLAT, 2 * FH, G, cidx);
        EpiFFNIn E{(const float*)(P.ws + WS_SSP1), (const float*)(P.ws + WS_BIAS2), (bf16_t*)(P.ws + WS_HID)};
        pg8::gemm_phase<EpiFFNIn, pg8::StaticOrder, true, true>(ldsl, g, S, E);
    } SEAM(9);
    if (IN(10)) {
        pg8::Gemm g{(const bf16_t*)(P.ws + WS_HID), (const bf16_t*)(P.ws + WS_WFO), FH, FH, FH};
        pg8::StaticOrder S; S.init(MLAT, DM, G, cidx);
        EpiFFNOut E{mod, (bf16_t*)(P.ws + WS_F), (float*)(P.ws + WS_SSP2)};
        pg8::gemm_phase<EpiFFNOut, pg8::StaticOrder, true, true>(ldsl, g, S, E);
    } SEAM(10);
    if (IN(11)) { phase_final(P); }
    (void)ws16;
#undef IN
#undef SEAM
}

extern "C" void kernel_launch(void* const* d_in, const int* in_sizes, int n_in, void* d_out, int out_size, void* d_ws, size_t ws_size, hipStream_t stream) {
    static int grid = 0;
    if (grid == 0) {
        int dev = 0, cus = 0, per_cu = 0;
        (void)hipGetDevice(&dev);
        (void)hipDeviceGetAttribute(&cus, hipDeviceAttributeMultiprocessorCount, dev);
        (void)hipFuncSetAttribute((const void*)fwd_kernel, hipFuncAttributeMaxDynamicSharedMemorySize, LDS_BYTES);
        (void)hipOccupancyMaxActiveBlocksPerMultiprocessor(&per_cu, (const void*)fwd_kernel, 512, LDS_BYTES);
        if (per_cu < 1) { fprintf(stderr, "kernel_launch: occupancy query says %d blocks per CU\n", per_cu); per_cu = 1; }
        grid = cus;
        if (ws_size < WS_END) fprintf(stderr, "kernel_launch: workspace too small: %zu < %zu\n", ws_size, (size_t)WS_END);
    }
    Params p{};
    const float** pp = (const float**)&p;
    for (int i = 0; i < 25; ++i) pp[i] = (const float*)d_in[i];
    p.out = (float*)d_out; p.ws = (unsigned char*)d_ws;
#if ONE_LAUNCH
    (void)hipMemsetAsync((unsigned char*)d_ws + WS_BAR, 0, 4096 + XCD_BAR_WORDS * 4, stream);
    p.ph_lo = 0; p.ph_hi = NPHASE;
    void* args[] = {&p};
    hipError_t e = hipLaunchCooperativeKernel((const void*)fwd_kernel, dim3(grid), dim3(512), args, LDS_BYTES, stream);
    if (e != hipSuccess) fprintf(stderr, "cooperative launch failed: %s (grid %d)\n", hipGetErrorString(e), grid);
#else
    for (int ph = 0; ph < NPHASE; ++ph) {
        p.ph_lo = ph; p.ph_hi = ph + 1;
        hipLaunchKernelGGL(fwd_kernel, dim3(grid), dim3(512), LDS_BYTES, stream, p);
    }
#endif
}
```

```cpp
#include <hip/hip_runtime.h>
#include <hip/hip_cooperative_groups.h>
#include <cstdio>
namespace cg = cooperative_groups;

#ifndef ONE_LAUNCH
#define ONE_LAUNCH 1
#endif

#define LAS __attribute__((address_space(3)))
typedef unsigned short bf16_t;
typedef short bf16x8 __attribute__((ext_vector_type(8)));
typedef float f32x4 __attribute__((ext_vector_type(4)));
typedef float f32x2 __attribute__((ext_vector_type(2)));
typedef unsigned u32x4 __attribute__((ext_vector_type(4)));
typedef unsigned u32x2 __attribute__((ext_vector_type(2)));

constexpr int NB = 8, SEQL = 4096, DM = 1024, LCTX = 256, NH = 8, HD = 64, AW = 512, SW = 512, NG = 32, NP = 64, HG = 16, FH = 2816, INC = 4096;
constexpr int MLAT = NB * SEQL;
constexpr int MCTX = NB * LCTX;
constexpr int MALL = MLAT + MCTX;
constexpr int XH_ROWS = 2304;
constexpr float NORM_EPS = 1e-6f;
constexpr float LOG2E = 1.4426950408889634f;

constexpr size_t MiB = (size_t)1 << 20;
constexpr size_t WS_MOD = 0;
constexpr size_t WS_ROPE = 256 * 1024;
constexpr size_t WS_LBT = WS_ROPE + 16 * 1024;
constexpr size_t WS_SS1 = 512 * 1024;
constexpr size_t WS_SS2 = 640 * 1024;
constexpr size_t WS_BIAS2 = 768 * 1024;
constexpr size_t WS_BAR = 1024 * 1024;
constexpr size_t WS_WIN = 2 * MiB;
constexpr size_t WS_WGLU = 10 * MiB;
constexpr size_t WS_WBA = 11 * MiB;
constexpr size_t WS_WBS = 12 * MiB;
constexpr size_t WS_WOUT = 13 * MiB;
constexpr size_t WS_WFI = 15 * MiB;
constexpr size_t WS_WFO = 26 * MiB;
constexpr size_t WS_S5W1 = 32 * MiB;
constexpr size_t WS_S5M2 = 36 * MiB;
constexpr size_t WS_A = 44 * MiB;
constexpr size_t WS_B = 112 * MiB;
constexpr size_t WS_C = 144 * MiB;
constexpr size_t WS_D = 212 * MiB;
constexpr size_t WS_F = 284 * MiB;
constexpr size_t WS_E = 412 * MiB;
constexpr size_t WS_SSP1 = 484 * MiB;
constexpr size_t WS_SSP2 = 486 * MiB;
constexpr size_t WS_END = 488 * MiB;
constexpr size_t WS_HID = WS_A;

typedef __bf16 bf16x2_t __attribute__((ext_vector_type(2)));
__device__ __forceinline__ unsigned cvt_pk_bf16(float lo, float hi) { f32x2 f = {lo, hi}; bf16x2_t v = __builtin_convertvector(f, bf16x2_t); return __builtin_bit_cast(unsigned, v); }
__device__ __forceinline__ bf16_t f2bf(float v) { return (bf16_t)(cvt_pk_bf16(v, 0.f) & 0xffffu); }
__device__ __forceinline__ float bf2f(unsigned short b) { return __uint_as_float(((unsigned)b) << 16); }
__device__ __forceinline__ float bflo(unsigned w) { return __uint_as_float(w << 16); }
__device__ __forceinline__ float bfhi(unsigned w) { return __uint_as_float(w & 0xffff0000u); }
__device__ __forceinline__ float xmax32(float x) { auto r = __builtin_amdgcn_permlane32_swap(__float_as_uint(x), __float_as_uint(x), false, false); return fmaxf(__uint_as_float(r[0]), __uint_as_float(r[1])); }
__device__ __forceinline__ float xmax16(float x) { auto r = __builtin_amdgcn_permlane16_swap(__float_as_uint(x), __float_as_uint(x), false, false); return fmaxf(__uint_as_float(r[0]), __uint_as_float(r[1])); }
__device__ __forceinline__ float xsum32(float x) { auto r = __builtin_amdgcn_permlane32_swap(__float_as_uint(x), __float_as_uint(x), false, false); return __uint_as_float(r[0]) + __uint_as_float(r[1]); }
__device__ __forceinline__ float xsum16(float x) { auto r = __builtin_amdgcn_permlane16_swap(__float_as_uint(x), __float_as_uint(x), false, false); return __uint_as_float(r[0]) + __uint_as_float(r[1]); }
__device__ __forceinline__ float fast_sigmoid(float x) { return __builtin_amdgcn_rcpf(1.0f + __builtin_amdgcn_exp2f(-x * LOG2E)); }

namespace pg8 {
constexpr int BM = 256, BK = 64, HALF = 128, HTB = HALF * BK * 2, STAGE_BYTES = 8 * HTB, NXCD = 8, WGM = 8;
__host__ __device__ __forceinline__ int lds_byte(int r, int c) { const int st = (r >> 4) * 2 + (c >> 5), rr = r & 15, cc = c & 31, ob = rr * 64 + cc * 2; return st * 1024 + (ob ^ (((ob >> 9) & 1) << 5)); }
__host__ __device__ __forceinline__ void stage_rc(int b, int& R, int& C) { const int st = b / 1024, sb = b % 1024, swz = sb ^ (((sb >> 9) & 1) << 5); R = (st >> 1) * 16 + swz / 64; C = (st & 1) * 32 + (swz % 64) / 2; }
__host__ __device__ __forceinline__ int perm32(int rho) { const int n = rho >> 4, i = rho & 15; return 8 * (i >> 2) + 4 * n + (i & 3); }

struct Unit { int pm, pn; };
struct Gemm { const bf16_t* A; const bf16_t* Bt; int lda, ldb, K; };

struct StaticOrder {
    int nM, nN, nwg, G, c;
    __device__ void init(int M, int N, int G_, int c_) { nM = M / BM; nN = N / BM; nwg = nM * nN; G = G_; c = c_; }
    __device__ bool map(long L, Unit& u) const {
        if (L >= nwg) return false;
        int wgid = (int)L; { const int q = nwg / NXCD, r = nwg % NXCD, xcd = wgid % NXCD, off = wgid / NXCD; wgid = (xcd < r ? xcd * (q + 1) : r * (q + 1) + (xcd - r) * q) + off; }
        const int nig = WGM * nN, gid = wgid / nig, fm = gid * WGM, gsz = (nM - fm) < WGM ? (nM - fm) : WGM;
        u.pm = fm + ((wgid % nig) % gsz); u.pn = (wgid % nig) / gsz; return true;
    }
    __device__ bool next(int i, Unit& u) const { return map((long)i * G + c, u); }
};
struct CtxOrder {
    int Gc, c;
    __device__ bool next(int i, Unit& u) const { const int j = i * Gc + c; if (j >= 48) return false; u.pm = 128 + j / 6; u.pn = 2 + j % 6; return true; }
};
template <int NT> struct S5Order {
    int G, c;
    __device__ void init(int G_, int c_) { G = G_; c = c_; }
    __device__ bool next(int i, Unit& u) const {
        const long L = (long)i * G + c; if (L >= 32 * NT) return false;
        const int g = (int)L / NT, t = (int)L % NT; u.pm = g * 9 + t; u.pn = g; return true;
    }
};

template <class Epi, class Sched, bool ALIGN_EPI = false, bool SP2 = false>
__device__ __forceinline__ void gemm_phase(LAS unsigned char* lds, const Gemm g, const Sched& S, const Epi& E) {
    const int tid = threadIdx.x, wid = __builtin_amdgcn_readfirstlane(tid >> 6), lane = tid & 63, wr = wid >> 2, wc = wid & 3, fr = lane & 15, fq = lane >> 4;
    const int K = g.K, nt = K / BK;
    unsigned voffA[2], voffB[2];
#pragma unroll
    for (int i = 0; i < 2; ++i) { int R, C; stage_rc(tid * 16 + i * 8192, R, C); const int Rb = Epi::PERM ? ((R & ~31) + perm32(R & 31)) : R;
        voffA[i] = (unsigned)(R * g.lda + C) * 2u; voffB[i] = (unsigned)(Rb * g.ldb + C) * 2u; }
    const size_t kstep = (size_t)(BK * 2);
    const size_t hstepA = (size_t)HALF * g.lda * 2, hstepB = (size_t)HALF * g.ldb * 2;
    const size_t tstepA = 2 * hstepA, tstepB = 2 * hstepB;
    const unsigned ldsw = (unsigned)wid * 1024u;
    const int aoff = lds_byte(wr * 64 + fr, fq * 8), boff = lds_byte(wc * 32 + fr, fq * 8);
#define PG8_SA(b, h) (((b) * 2 + (h)) * HTB)
#define PG8_SB(b, h) ((4 + (b) * 2 + (h)) * HTB)
#define PG8_STAGE(bufoff, gbase, voff) do { _Pragma("unroll") for (int _i = 0; _i < 2; ++_i) \
        __builtin_amdgcn_global_load_lds((const unsigned*)((const char*)(gbase) + (voff)[_i]), (LAS unsigned*)(lds + (bufoff) + ldsw + _i * 8192), 16, 0, 0); } while (0)
#define PG8_LDA(dst, b, h) do { _Pragma("unroll") for (int m = 0; m < 4; ++m) _Pragma("unroll") for (int k = 0; k < 2; ++k) dst[m][k] = *(const LAS bf16x8*)(lds + PG8_SA(b, h) + aoff + m * 2048 + k * 1024); } while (0)
#define PG8_LDB(dst, b, h) do { _Pragma("unroll") for (int n = 0; n < 2; ++n) _Pragma("unroll") for (int k = 0; k < 2; ++k) dst[n][k] = *(const LAS bf16x8*)(lds + PG8_SB(b, h) + boff + n * 2048 + k * 1024); } while (0)
#define PG8_MMA(ai, bj, At, Bt) do { __builtin_amdgcn_s_setprio(1); _Pragma("unroll") for (int m = 0; m < 4; ++m) _Pragma("unroll") for (int n = 0; n < 2; ++n) _Pragma("unroll") for (int k = 0; k < 2; ++k) \
        acc[ai][bj][m][n] = __builtin_amdgcn_mfma_f32_16x16x32_bf16(Bt[n][k], At[m][k], acc[ai][bj][m][n], 0, 0, 0); __builtin_amdgcn_s_setprio(0); } while (0)
#define PG8_WAIT_V(n) asm volatile("s_waitcnt vmcnt(" #n ")" ::: "memory")
#define PG8_WAIT_L(n) asm volatile("s_waitcnt lgkmcnt(" #n ")" ::: "memory")
#define PG8_BAR __builtin_amdgcn_s_barrier()
#define PG8_SCHED __builtin_amdgcn_sched_barrier(0)
    Unit cur, nxt; int ui = 0;
    if (!S.next(0, cur)) return;
    f32x4 acc[2][2][4][2];
#pragma unroll
    for (int a = 0; a < 2; ++a)
#pragma unroll
        for (int b = 0; b < 2; ++b)
#pragma unroll
            for (int m = 0; m < 4; ++m)
#pragma unroll
                for (int n = 0; n < 2; ++n) acc[a][b][m][n] = (f32x4){0.f, 0.f, 0.f, 0.f};
    bf16x8 At[4][2], B0[2][2], B1[2][2];
    const char* cA = (const char*)g.A + (size_t)cur.pm * tstepA; const char* cB = (const char*)g.Bt + (size_t)cur.pn * tstepB;
    if constexpr (SP2) {
        PG8_STAGE(PG8_SB(0, 0), cB, voffB); PG8_STAGE(PG8_SB(0, 1), cB + hstepB, voffB); PG8_STAGE(PG8_SA(0, 0), cA, voffA); PG8_STAGE(PG8_SA(0, 1), cA + hstepA, voffA);
        if (wr == 1) PG8_BAR;
        PG8_WAIT_V(2); PG8_BAR;
        PG8_STAGE(PG8_SB(1, 0), cB + kstep, voffB); PG8_STAGE(PG8_SA(1, 0), cA + kstep, voffA); PG8_STAGE(PG8_SB(1, 1), cB + hstepB + kstep, voffB);
        PG8_WAIT_V(6); PG8_BAR;
    } else {
        PG8_STAGE(PG8_SB(0, 0), cB, voffB); PG8_STAGE(PG8_SA(0, 0), cA, voffA); PG8_STAGE(PG8_SB(0, 1), cB + hstepB, voffB); PG8_STAGE(PG8_SA(0, 1), cA + hstepA, voffA);
        if (wr == 1) PG8_BAR;
        PG8_WAIT_V(4); PG8_BAR;
        PG8_STAGE(PG8_SB(1, 0), cB + kstep, voffB); PG8_STAGE(PG8_SA(1, 0), cA + kstep, voffA); PG8_STAGE(PG8_SB(1, 1), cB + hstepB + kstep, voffB);
        PG8_WAIT_V(6); PG8_BAR;
    }
    for (;;) {
        const bool has_next = S.next(ui + 1, nxt);
        const char* nA = has_next ? (const char*)g.A + (size_t)nxt.pm * tstepA : cA; const char* nB = has_next ? (const char*)g.Bt + (size_t)nxt.pn * tstepB : cB;
        for (int t = 0; t < nt; t += 2) {
            const bool last = (t == nt - 2);
            const char* a1 = cA + (size_t)(t + 1) * kstep;
            const char* a2 = last ? nA : cA + (size_t)(t + 2) * kstep; const char* b2 = last ? nB : cB + (size_t)(t + 2) * kstep;
            const char* a3 = a2 + kstep; const char* b3 = b2 + kstep;
            if constexpr (SP2) {
            PG8_LDB(B0, 0, 0); PG8_LDB(B1, 0, 1); PG8_SCHED; PG8_LDA(At, 0, 0); PG8_STAGE(PG8_SA(1, 1), a1 + hstepA, voffA);
            PG8_WAIT_V(8); PG8_WAIT_L(0); PG8_BAR; PG8_MMA(0, 0, At, B0); PG8_MMA(0, 1, At, B1); PG8_BAR; PG8_SCHED;
            PG8_LDA(At, 0, 1); PG8_STAGE(PG8_SB(0, 0), b2, voffB); PG8_STAGE(PG8_SB(0, 1), b2 + hstepB, voffB); PG8_STAGE(PG8_SA(0, 0), a2, voffA);
            PG8_WAIT_V(8); PG8_WAIT_L(0); PG8_BAR; PG8_MMA(1, 0, At, B0); PG8_MMA(1, 1, At, B1); PG8_BAR; PG8_SCHED;
            PG8_LDB(B0, 1, 0); PG8_LDB(B1, 1, 1); PG8_SCHED; PG8_LDA(At, 1, 0); PG8_STAGE(PG8_SA(0, 1), a2 + hstepA, voffA);
            PG8_WAIT_V(8); PG8_WAIT_L(0); PG8_BAR; PG8_MMA(0, 0, At, B0); PG8_MMA(0, 1, At, B1); PG8_BAR; PG8_SCHED;
            PG8_LDA(At, 1, 1); PG8_STAGE(PG8_SB(1, 0), b3, voffB); PG8_STAGE(PG8_SB(1, 1), b3 + hstepB, voffB); PG8_STAGE(PG8_SA(1, 0), a3, voffA);
            PG8_WAIT_V(8); PG8_WAIT_L(0); PG8_BAR; PG8_MMA(1, 0, At, B0); PG8_MMA(1, 1, At, B1); PG8_BAR; PG8_SCHED;
            } else {
            PG8_LDB(B0, 0, 0); PG8_SCHED; PG8_LDA(At, 0, 0); PG8_STAGE(PG8_SA(1, 1), a1 + hstepA, voffA);
            PG8_WAIT_L(8); PG8_BAR; PG8_WAIT_L(0); PG8_MMA(0, 0, At, B0); PG8_BAR; PG8_SCHED;
            PG8_LDB(B1, 0, 1); PG8_STAGE(PG8_SB(0, 0), b2, voffB);
            PG8_BAR; PG8_WAIT_L(0); PG8_MMA(0, 1, At, B1); PG8_BAR;
            PG8_LDA(At, 0, 1); PG8_STAGE(PG8_SA(0, 0), a2, voffA);
            PG8_BAR; PG8_WAIT_L(0); PG8_MMA(1, 0, At, B0); PG8_BAR; PG8_SCHED;
            PG8_STAGE(PG8_SB(0, 1), b2 + hstepB, voffB);
            PG8_WAIT_V(6); PG8_BAR; PG8_MMA(1, 1, At, B1); PG8_BAR;
            PG8_LDB(B0, 1, 0); PG8_SCHED; PG8_LDA(At, 1, 0); PG8_STAGE(PG8_SA(0, 1), a2 + hstepA, voffA);
            PG8_WAIT_L(8); PG8_BAR; PG8_WAIT_L(0); PG8_MMA(0, 0, At, B0); PG8_BAR; PG8_SCHED;
            PG8_LDB(B1, 1, 1); PG8_STAGE(PG8_SB(1, 0), b3, voffB);
            PG8_BAR; PG8_WAIT_L(0); PG8_MMA(0, 1, At, B1); PG8_BAR;
            PG8_LDA(At, 1, 1); PG8_STAGE(PG8_SA(1, 0), a3, voffA);
            PG8_BAR; PG8_WAIT_L(0); PG8_MMA(1, 0, At, B0); PG8_BAR; PG8_SCHED;
            PG8_STAGE(PG8_SB(1, 1), b3 + hstepB, voffB);
            PG8_WAIT_V(6); PG8_BAR; PG8_MMA(1, 1, At, B1); PG8_BAR;
                    }
        }
        if constexpr (ALIGN_EPI) { if (wr == 0) PG8_BAR; }
        E(acc, cur, wr, wc, fr, fq);
        if (!has_next) break;
#pragma unroll
        for (int a = 0; a < 2; ++a)
#pragma unroll
            for (int b = 0; b < 2; ++b)
#pragma unroll
                for (int m = 0; m < 4; ++m)
#pragma unroll
                    for (int n = 0; n < 2; ++n) acc[a][b][m][n] = (f32x4){0.f, 0.f, 0.f, 0.f};
        cur = nxt; cA = nA; cB = nB; ++ui;
        if constexpr (ALIGN_EPI) { if (wr == 1) PG8_BAR; }
    }
    PG8_WAIT_V(0);
    if constexpr (!ALIGN_EPI) { if (wr == 0) PG8_BAR; }
    PG8_BAR;
#undef PG8_SA
#undef PG8_SB
#undef PG8_STAGE
#undef PG8_LDA
#undef PG8_LDB
#undef PG8_MMA
#undef PG8_WAIT_V
#undef PG8_WAIT_L
#undef PG8_BAR
#undef PG8_SCHED
}
}
using pg8::Unit;

#define EPI_ROWS_BEGIN _Pragma("unroll") for (int ai = 0; ai < 2; ++ai) _Pragma("unroll") for (int m = 0; m < 4; ++m) {
#define EPI_ROWS_END }

struct EpiInProj {
    static constexpr bool PERM = true;
    bf16_t *q, *k, *vt, *vtc, *xh, *sig; const f32x2* rope;
    __device__ __forceinline__ void operator()(const f32x4 (&acc)[2][2][4][2], const Unit& u, int wr, int wc, int fr, int fq) const {
        const int pn = u.pn; const bool isctx = u.pm >= 128;
        const int kind = pn < 2 ? 0 : pn < 4 ? 1 : pn < 6 ? 2 : pn < 8 ? 3 : 4;
        EPI_ROWS_BEGIN
            const int r = u.pm * 256 + ai * 128 + wr * 64 + m * 16 + fr;
#pragma unroll
            for (int bj = 0; bj < 2; ++bj) {
                const int c = pn * 256 + bj * 128 + wc * 32 + 8 * fq;
                f32x4 v0 = acc[ai][bj][m][0], v1 = acc[ai][bj][m][1];
                if (kind <= 1) {
                    if (!isctx) {
                        const int t = r & 4095; const int pos = (wc & 1) ? (t & 63) : (t >> 6);
                        const f32x4* cs = (const f32x4*)(rope + pos * 16 + 8 * (fq & 1));
                        const f32x4 cs0 = cs[0], cs1 = cs[1], cs2 = cs[2], cs3 = cs[3];
                        const float sg = (fq >> 1) ? 1.0f : -1.0f;
                        f32x4 p0, p1;
#pragma unroll
                        for (int j = 0; j < 4; ++j) { p0[j] = __shfl_xor(v0[j], 32); p1[j] = __shfl_xor(v1[j], 32); }
                        v0[0] = v0[0] * cs0[0] + sg * p0[0] * cs0[1]; v0[1] = v0[1] * cs0[2] + sg * p0[1] * cs0[3];
                        v0[2] = v0[2] * cs1[0] + sg * p0[2] * cs1[1]; v0[3] = v0[3] * cs1[2] + sg * p0[3] * cs1[3];
                        v1[0] = v1[0] * cs2[0] + sg * p1[0] * cs2[1]; v1[1] = v1[1] * cs2[2] + sg * p1[1] * cs2[3];
                        v1[2] = v1[2] * cs3[0] + sg * p1[2] * cs3[1]; v1[3] = v1[3] * cs3[2] + sg * p1[3] * cs3[3];
                    }
                    u32x4 w; w.x = cvt_pk_bf16(v0[0], v0[1]); w.y = cvt_pk_bf16(v0[2], v0[3]); w.z = cvt_pk_bf16(v1[0], v1[1]); w.w = cvt_pk_bf16(v1[2], v1[3]);
                    bf16_t* dst = (kind == 0) ? (q + (size_t)r * 512 + c) : (k + (size_t)r * 512 + (c - 512));
                    *(u32x4*)dst = w;
                } else if (kind == 2) {
                    const int cv = c - 1024, h = cv >> 6, d0 = cv & 63;
                    bf16_t* dst;
                    if (!isctx) { const int b = r >> 12, t = r & 4095; dst = vt + ((size_t)((b * 8 + h) * 512 + (t >> 3))) * 512 + d0 * 8 + (t & 7); }
                    else { const int rc = r - MLAT, b = rc >> 8, mm = rc & 255; dst = vtc + ((size_t)((b * 8 + h) * 32 + (mm >> 3))) * 512 + d0 * 8 + (mm & 7); }
#pragma unroll
                    for (int j = 0; j < 4; ++j) { dst[8 * j] = f2bf(v0[j]); dst[8 * (4 + j)] = f2bf(v1[j]); }
                } else if (kind == 3) {
                    const int cu = c - 1536, g = cu >> 4, h0 = cu & 15;
                    size_t row; int col;
                    if (!isctx) { const int b = r >> 12, t = r & 4095; row = (size_t)g * XH_ROWS + b * 256 + (t >> 4); col = (t & 15) * 16 + h0; }
                    else { const int rc = r - MLAT, b = rc >> 8, mm = rc & 255; row = (size_t)g * XH_ROWS + 2048 + b * 16 + (mm >> 4); col = (mm & 15) * 16 + h0; }
                    u32x4 w; w.x = cvt_pk_bf16(v0[0], v0[1]); w.y = cvt_pk_bf16(v0[2], v0[3]); w.z = cvt_pk_bf16(v1[0], v1[1]); w.w = cvt_pk_bf16(v1[2], v1[3]);
                    *(u32x4*)(xh + row * 512 + col) = w;
                } else {
                    u32x4 w; w.x = cvt_pk_bf16(fast_sigmoid(v0[0]), fast_sigmoid(v0[1])); w.y = cvt_pk_bf16(fast_sigmoid(v0[2]), fast_sigmoid(v0[3]));
                    w.z = cvt_pk_bf16(fast_sigmoid(v1[0]), fast_sigmoid(v1[1])); w.w = cvt_pk_bf16(fast_sigmoid(v1[2]), fast_sigmoid(v1[3]));
                    *(u32x4*)(sig + (size_t)r * 2048 + (c - 2048)) = w;
                }
            }
        EPI_ROWS_END
    }
};

struct EpiE {
    static constexpr bool PERM = false;
    float* E;
    __device__ __forceinline__ void operator()(const f32x4 (&acc)[2][2][4][2], const Unit& u, int wr, int wc, int fr, int fq) const {
        EPI_ROWS_BEGIN
            const int r = u.pm * 256 + ai * 128 + wr * 64 + m * 16 + fr;
            float* rowp = E + (size_t)r * 256 + wc * 32 + 4 * fq;
#pragma unroll
            for (int bj = 0; bj < 2; ++bj)
#pragma unroll
                for (int n = 0; n < 2; ++n) *(f32x4*)(rowp + bj * 128 + n * 16) = acc[ai][bj][m][n];
        EPI_ROWS_END
    }
};

__device__ __forceinline__ float gelu_tanh(float x) {
    const float z = 1.5957691216057308f * (x + 0.044715f * x * x * x);
    return x * fast_sigmoid(z);
}

struct EpiY {
    static constexpr bool PERM = true;
    const bf16_t* xh; const float* dsk; bf16_t* y;
    __device__ __forceinline__ void operator()(const f32x4 (&acc)[2][2][4][2], const Unit& u, int wr, int wc, int fr, int fq) const {
        const int g = u.pn, it = u.pm - g * 9;
        const int rr0 = wr * 64 + fr, c00 = wc * 32 + 8 * fq, h0 = c00 & 15;
        u32x4 uu[2][4][2];
#pragma unroll
        for (int ai = 0; ai < 2; ++ai)
#pragma unroll
            for (int m = 0; m < 4; ++m)
#pragma unroll
                for (int bj = 0; bj < 2; ++bj) uu[ai][m][bj] = *(const u32x4*)(xh + ((size_t)u.pm * 256 + rr0 + ai * 128 + m * 16) * 512 + c00 + bj * 128);
        const f32x4 d0 = *(const f32x4*)(dsk + g * 16 + h0), d1 = *(const f32x4*)(dsk + g * 16 + h0 + 4);
        EPI_ROWS_BEGIN
            const int rr = rr0 + ai * 128 + m * 16;
            const int idx = it * 256 + rr, b = idx >> 8, cch = idx & 255;
#pragma unroll
            for (int bj = 0; bj < 2; ++bj) {
                const int t = (c00 + bj * 128) >> 4;
                const u32x4 w4 = uu[ai][m][bj];
                const f32x4 v0 = acc[ai][bj][m][0], v1 = acc[ai][bj][m][1];
                float o[8];
                o[0] = v0[0] + d0[0] * bflo(w4.x); o[1] = v0[1] + d0[1] * bfhi(w4.x); o[2] = v0[2] + d0[2] * bflo(w4.y); o[3] = v0[3] + d0[3] * bfhi(w4.y);
                o[4] = v1[0] + d1[0] * bflo(w4.z); o[5] = v1[1] + d1[1] * bfhi(w4.z); o[6] = v1[2] + d1[2] * bflo(w4.w); o[7] = v1[3] + d1[3] * bfhi(w4.w);
#pragma unroll
                for (int j = 0; j < 8; ++j) o[j] = gelu_tanh(o[j]);
                u32x4 w; w.x = cvt_pk_bf16(o[0], o[1]); w.y = cvt_pk_bf16(o[2], o[3]); w.z = cvt_pk_bf16(o[4], o[5]); w.w = cvt_pk_bf16(o[6], o[7]);
                *(u32x4*)(y + ((size_t)(b * 4096 + cch * 16 + t)) * 512 + g * 16 + h0) = w;
            }
        EPI_ROWS_END
    }
};

struct EpiGLU {
    static constexpr bool PERM = true;
    bf16_t* o; int ld;
    __device__ __forceinline__ void operator()(const f32x4 (&acc)[2][2][4][2], const Unit& u, int wr, int wc, int fr, int fq) const {
        EPI_ROWS_BEGIN
            const int r = u.pm * 256 + ai * 128 + wr * 64 + m * 16 + fr;
            const int oc = u.pn * 128 + wc * 32 + 8 * fq;
            const f32x4 a0 = acc[ai][0][m][0], a1 = acc[ai][0][m][1], g0 = acc[ai][1][m][0], g1 = acc[ai][1][m][1];
            u32x4 w; w.x = cvt_pk_bf16(a0[0] * fast_sigmoid(g0[0]), a0[1] * fast_sigmoid(g0[1])); w.y = cvt_pk_bf16(a0[2] * fast_sigmoid(g0[2]), a0[3] * fast_sigmoid(g0[3]));
            w.z = cvt_pk_bf16(a1[0] * fast_sigmoid(g1[0]), a1[1] * fast_sigmoid(g1[1])); w.w = cvt_pk_bf16(a1[2] * fast_sigmoid(g1[2]), a1[3] * fast_sigmoid(g1[3]));
            *(u32x4*)(o + (size_t)r * ld + oc) = w;
        EPI_ROWS_END
    }
};

template <int SECOND> struct EpiBranch {
    static constexpr bool PERM = true;
    const bf16_t* sig; bf16_t* mb;
    __device__ __forceinline__ void operator()(const f32x4 (&acc)[2][2][4][2], const Unit& u, int wr, int wc, int fr, int fq) const {
        const int r0 = u.pm * 256 + wr * 64 + fr, c00 = u.pn * 256 + wc * 32 + 8 * fq;
#pragma unroll
        for (int ai = 0; ai < 2; ++ai) {
            u32x4 sg[4][2], pv[4][2];
#pragma unroll
            for (int m = 0; m < 4; ++m)
#pragma unroll
                for (int bj = 0; bj < 2; ++bj) { const size_t r = (size_t)(r0 + ai * 128 + m * 16);
                    sg[m][bj] = *(const u32x4*)(sig + r * 2048 + c00 + bj * 128);
                    if (SECOND) pv[m][bj] = *(const u32x4*)(mb + r * 1024 + c00 + bj * 128); }
#pragma unroll
            for (int m = 0; m < 4; ++m)
#pragma unroll
                for (int bj = 0; bj < 2; ++bj) {
                    const u32x4 sv = sg[m][bj];
                    const f32x4 v0 = acc[ai][bj][m][0], v1 = acc[ai][bj][m][1];
                    float o[8];
                    o[0] = v0[0] * bflo(sv.x); o[1] = v0[1] * bfhi(sv.x); o[2] = v0[2] * bflo(sv.y); o[3] = v0[3] * bfhi(sv.y);
                    o[4] = v1[0] * bflo(sv.z); o[5] = v1[1] * bfhi(sv.z); o[6] = v1[2] * bflo(sv.w); o[7] = v1[3] * bfhi(sv.w);
                    if (SECOND) { const u32x4 pp = pv[m][bj];
                        o[0] += bflo(pp.x); o[1] += bfhi(pp.x); o[2] += bflo(pp.y); o[3] += bfhi(pp.y); o[4] += bflo(pp.z); o[5] += bfhi(pp.z); o[6] += bflo(pp.w); o[7] += bfhi(pp.w); }
                    u32x4 w; w.x = cvt_pk_bf16(o[0], o[1]); w.y = cvt_pk_bf16(o[2], o[3]); w.z = cvt_pk_bf16(o[4], o[5]); w.w = cvt_pk_bf16(o[6], o[7]);
                    *(u32x4*)(mb + (size_t)(r0 + ai * 128 + m * 16) * 1024 + c00 + bj * 128) = w;
                }
        }
    }
};

struct EpiWout {
    static constexpr bool PERM = true;
    const float* x; const float* mod; const float* gffn; bf16_t* out; bf16_t* ap; float* ss;
    __device__ __forceinline__ void operator()(const f32x4 (&acc)[2][2][4][2], const Unit& u, int wr, int wc, int fr, int fq) const {
        const int b = u.pm >> 4;
        const float* g1 = mod + b * 6144 + 2 * 1024; const float* sc2 = mod + b * 6144 + 4 * 1024;
        const int r0 = u.pm * 256 + wr * 64 + fr, c00 = u.pn * 256 + wc * 32 + 8 * fq;
        f32x4 gv[2][2], gs[2][2];
#pragma unroll
        for (int bj = 0; bj < 2; ++bj)
#pragma unroll
            for (int n = 0; n < 2; ++n) { const int c = c00 + bj * 128 + 4 * n; gv[bj][n] = *(const f32x4*)(g1 + c); gs[bj][n] = *(const f32x4*)(gffn + c) * (*(const f32x4*)(sc2 + c) + 1.0f); }
#pragma unroll
        for (int ai = 0; ai < 2; ++ai)
#pragma unroll
        for (int mh = 0; mh < 2; ++mh) {
            f32x4 xv[2][2][2];
#pragma unroll
            for (int m2 = 0; m2 < 2; ++m2)
#pragma unroll
                for (int bj = 0; bj < 2; ++bj)
#pragma unroll
                    for (int n = 0; n < 2; ++n) xv[m2][bj][n] = *(const f32x4*)(x + (size_t)(r0 + ai * 128 + (mh * 2 + m2) * 16) * 1024 + c00 + bj * 128 + 4 * n);
#pragma unroll
            for (int m2 = 0; m2 < 2; ++m2) { const int m = mh * 2 + m2;
                const size_t r = (size_t)(r0 + ai * 128 + m * 16);
                float sq = 0.f;
#pragma unroll
                for (int bj = 0; bj < 2; ++bj)
#pragma unroll
                    for (int n = 0; n < 2; ++n) {
                        const int c = c00 + bj * 128 + 4 * n;
                        const f32x4 h = xv[m2][bj][n] + gv[bj][n] * acc[ai][bj][m][n];
                        { u32x2 hw; hw.x = cvt_pk_bf16(h[0], h[1]); hw.y = cvt_pk_bf16(h[2], h[3]); *(u32x2*)(out + r * 1024 + c) = hw; }
                        sq += h[0] * h[0] + h[1] * h[1] + h[2] * h[2] + h[3] * h[3];
                        const f32x4 a = h * gs[bj][n];
                        u32x2 w; w.x = cvt_pk_bf16(a[0], a[1]); w.y = cvt_pk_bf16(a[2], a[3]);
                        *(u32x2*)(ap + r * 1024 + c) = w;
                    }
                sq = xsum16(xsum32(sq));
                if (fq == 0) ss[r * 16 + u.pn * 4 + wc] = sq;
            }
        }
    }
};

struct EpiFFNIn {
    static constexpr bool PERM = true;
    const float* ss; const float* bias2; bf16_t* hid;
    __device__ __forceinline__ void operator()(const f32x4 (&acc)[2][2][4][2], const Unit& u, int wr, int wc, int fr, int fq) const {
        const int b = u.pm >> 4;
        const int r0 = u.pm * 256 + wr * 64 + fr, c00 = u.pn * 256 + wc * 32 + 8 * fq, oc = u.pn * 128 + wc * 32 + 8 * fq;
        f32x4 sp[8], ba[2], bb[2];
#pragma unroll
        for (int i = 0; i < 8; ++i) sp[i] = *(const f32x4*)(ss + (size_t)(r0 + (i >> 2) * 128 + (i & 3) * 16) * 16 + 4 * fq);
#pragma unroll
        for (int n = 0; n < 2; ++n) { ba[n] = *(const f32x4*)(bias2 + b * 5632 + c00 + 4 * n); bb[n] = *(const f32x4*)(bias2 + b * 5632 + c00 + 128 + 4 * n); }
        float rstd[8];
#pragma unroll
        for (int i = 0; i < 8; ++i) { float t = (sp[i][0] + sp[i][1]) + (sp[i][2] + sp[i][3]); t = xsum16(xsum32(t)); rstd[i] = 1.0f / sqrtf(t * (1.0f / 1024.0f) + NORM_EPS); }
        EPI_ROWS_BEGIN
            const int r = r0 + ai * 128 + m * 16;
            u32x4 w;
#pragma unroll
            for (int n = 0; n < 2; ++n) {
                const f32x4 va = acc[ai][0][m][n] * rstd[ai * 4 + m] + ba[n], vb = acc[ai][1][m][n] * rstd[ai * 4 + m] + bb[n];
                const unsigned lo = cvt_pk_bf16(va[0] * fast_sigmoid(va[0]) * vb[0], va[1] * fast_sigmoid(va[1]) * vb[1]);
                const unsigned hi = cvt_pk_bf16(va[2] * fast_sigmoid(va[2]) * vb[2], va[3] * fast_sigmoid(va[3]) * vb[3]);
                if (n == 0) { w.x = lo; w.y = hi; } else { w.z = lo; w.w = hi; }
            }
            *(u32x4*)(hid + (size_t)r * FH + oc) = w;
        EPI_ROWS_END
    }
};

struct EpiFFNOut {
    static constexpr bool PERM = true;
    const float* mod; bf16_t* out; float* ss;
    __device__ __forceinline__ void operator()(const f32x4 (&acc)[2][2][4][2], const Unit& u, int wr, int wc, int fr, int fq) const {
        const int b = u.pm >> 4;
        const float* g2 = mod + b * 6144 + 5 * 1024;
        const int r0 = u.pm * 256 + wr * 64 + fr, c00 = u.pn * 256 + wc * 32 + 8 * fq;
        f32x4 gv[2][2];
#pragma unroll
        for (int bj = 0; bj < 2; ++bj)
#pragma unroll
            for (int n = 0; n < 2; ++n) gv[bj][n] = *(const f32x4*)(g2 + c00 + bj * 128 + 4 * n);
#pragma unroll
        for (int ai = 0; ai < 2; ++ai) {
            u32x2 hv[4][2][2];
#pragma unroll
            for (int m = 0; m < 4; ++m)
#pragma unroll
                for (int bj = 0; bj < 2; ++bj)
#pragma unroll
                    for (int n = 0; n < 2; ++n) hv[m][bj][n] = *(const u32x2*)(out + (size_t)(r0 + ai * 128 + m * 16) * 1024 + c00 + bj * 128 + 4 * n);
#pragma unroll
            for (int m = 0; m < 4; ++m) {
                const size_t r = (size_t)(r0 + ai * 128 + m * 16);
                float sq = 0.f;
#pragma unroll
                for (int bj = 0; bj < 2; ++bj)
#pragma unroll
                    for (int n = 0; n < 2; ++n) {
                        const u32x2 hq = hv[m][bj][n];
                        const f32x4 h = (f32x4){bflo(hq.x), bfhi(hq.x), bflo(hq.y), bfhi(hq.y)} + gv[bj][n] * acc[ai][bj][m][n];
                        { u32x2 hw; hw.x = cvt_pk_bf16(h[0], h[1]); hw.y = cvt_pk_bf16(h[2], h[3]); *(u32x2*)(out + r * 1024 + c00 + bj * 128 + 4 * n) = hw; }
                        sq += h[0] * h[0] + h[1] * h[1] + h[2] * h[2] + h[3] * h[3];
                    }
                sq = xsum16(xsum32(sq));
                if (fq == 0) ss[r * 16 + u.pn * 4 + wc] = sq;
            }
        }
    }
};

struct Params {
    const float *x, *c, *ctx, *c_ctx, *w_mod, *b_mod, *attn_g, *ffn_g, *w_in, *rpb, *lam_re, *lam_im, *log_dt, *b_re, *b_im, *c_re, *c_im, *ssm_d,
        *w_glu, *w_ba, *w_bs, *w_out, *w_fi, *w_fo, *final_g;
    float* out; unsigned char* ws;
    int ph_lo, ph_hi;
};

__device__ __forceinline__ void sincos_d(double a, float& s, float& c) {
    const double inv2pi = 0.15915494309189533577, twopi = 6.283185307179586477;
    double x = a - twopi * __builtin_rint(a * inv2pi);
    const double x2 = x * x;
    double ts = 1.0, tc = 1.0;
    ts = 1.0; tc = 1.0;
#pragma unroll
    for (int k = 13; k >= 1; --k) { ts = 1.0 - x2 * ts * (1.0 / (double)((2 * k) * (2 * k + 1))); tc = 1.0 - x2 * tc * (1.0 / (double)((2 * k - 1) * (2 * k))); }
    s = (float)(x * ts); c = (float)tc;
}

__device__ void tr_strip(const float* __restrict__ src, int N, int K, int ks, int nt, bf16_t* __restrict__ dst, int half, unsigned short* T) {
    const int tid = threadIdx.x;
    { const int n = tid & 63, kb = tid >> 6; float v[32];
      const float* sp = src + (size_t)(ks * 256 + kb) * N + nt * 64 + n;
#pragma unroll
      for (int i = 0; i < 32; ++i) v[i] = sp[(size_t)(8 * i) * N];
#pragma unroll
      for (int i = 0; i < 32; ++i) T[(kb + 8 * i) * 66 + n] = f2bf(v[i]); }
    __syncthreads();
    { const int nn = tid >> 3, kc = (tid & 7) * 8; const int ncol = nt * 64 + nn;
      int drow = ncol;
      if (half) drow = ncol < half ? ((ncol >> 7) * 256 + (ncol & 127)) : (((ncol - half) >> 7) * 256 + 128 + ((ncol - half) & 127));
#pragma unroll
      for (int q = 0; q < 4; ++q) { const int kk = q * 64 + kc; unsigned short v[8];
#pragma unroll
        for (int j = 0; j < 8; ++j) v[j] = T[(kk + j) * 66 + nn];
        u32x4 w; w.x = v[0] | ((unsigned)v[1] << 16); w.y = v[2] | ((unsigned)v[3] << 16); w.z = v[4] | ((unsigned)v[5] << 16); w.w = v[6] | ((unsigned)v[7] << 16);
        *(u32x4*)(dst + (size_t)drow * K + ks * 256 + kk) = w; } }
    __syncthreads();
}

template <int NR>
__device__ void gemv_tile(const float* __restrict__ W, int N, int n0, const float* A_lds, float* red, float (&res)[2], int (&ridx)[2]) {
    const int tid = threadIdx.x, col = tid & 63, ks = tid >> 6;
    float acc[NR];
#pragma unroll
    for (int r = 0; r < NR; ++r) acc[r] = 0.f;
    const float* wp = W + (size_t)(ks * 128) * N + n0 + col;
#pragma unroll 16
    for (int k = 0; k < 128; ++k) { const float w = wp[(size_t)k * N];
#pragma unroll
        for (int r = 0; r < NR; ++r) acc[r] += A_lds[r * 1024 + ks * 128 + k] * w; }
#pragma unroll
    for (int r = 0; r < NR; ++r) red[(ks * NR + r) * 64 + col] = acc[r];
    __syncthreads();
#pragma unroll
    for (int e = 0; e < 2; ++e) { const int idx = tid + e * 512; ridx[e] = idx; float s = 0.f;
        if (idx < NR * 64) { const int r = idx >> 6, cc = idx & 63;
#pragma unroll
            for (int k8 = 0; k8 < 8; ++k8) s += red[(k8 * NR + r) * 64 + cc]; }
        res[e] = s; }
    __syncthreads();
}

__device__ void s5_build(const Params& P, int g, float* L) {
    float* lbp = L; float* Bb = L + 4352; float* Cc = L + 8448; float* Kt = L + 12544;
    const int tid = threadIdx.x;
#pragma unroll 5
    for (int idx = tid; idx < 2 * 17 * 64; idx += 512) {
        const int p = idx & 63, d = (idx >> 6) % 17, dir = idx / (17 * 64);
        const float dt = expf(P.log_dt[dir * 32 + g]);
        const float lr = P.lam_re[(dir * 32 + g) * 64 + p], li = P.lam_im[(dir * 32 + g) * 64 + p];
        const float mag = expf(lr * dt * (float)d); float s, c; sincos_d((double)li * (double)dt * (double)d, s, c);
        lbp[((dir * 17 + d) * 64 + p) * 2] = mag * c; lbp[((dir * 17 + d) * 64 + p) * 2 + 1] = mag * s;
    }
#pragma unroll 4
    for (int idx = tid; idx < 2 * 16 * 64; idx += 512) {
        const int p = idx & 63, h = (idx >> 6) & 15, dir = idx >> 10;
        Cc[((dir * 64 + p) * 16 + h) * 2] = P.c_re[((dir * 32 + g) * 16 + h) * 64 + p]; Cc[((dir * 64 + p) * 16 + h) * 2 + 1] = P.c_im[((dir * 32 + g) * 16 + h) * 64 + p];
    }
    __syncthreads();
#pragma unroll 4
    for (int idx = tid; idx < 2 * 64 * 16; idx += 512) {
        const int h = idx & 15, p = (idx >> 4) & 63, dir = idx >> 10;
        const float lr = P.lam_re[(dir * 32 + g) * 64 + p], li = P.lam_im[(dir * 32 + g) * 64 + p];
        const float nr = lbp[((dir * 17 + 1) * 64 + p) * 2] - 1.0f, ni = lbp[((dir * 17 + 1) * 64 + p) * 2 + 1];
        const float den = lr * lr + li * li;
        const float fre = (nr * lr + ni * li) / den, fim = (ni * lr - nr * li) / den;
        const float br = P.b_re[((dir * 32 + g) * 64 + p) * 16 + h], bi = P.b_im[((dir * 32 + g) * 64 + p) * 16 + h];
        Bb[((dir * 64 + p) * 16 + h) * 2] = fre * br - fim * bi; Bb[((dir * 64 + p) * 16 + h) * 2 + 1] = fre * bi + fim * br;
    }
    if (tid < 128) { const int p = tid & 63, dir = tid >> 6;
        ((f32x2*)(P.ws + WS_LBT))[(dir * 32 + g) * 64 + p] = (f32x2){lbp[((dir * 17 + 16) * 64 + p) * 2], lbp[((dir * 17 + 16) * 64 + p) * 2 + 1]}; }
    __syncthreads();
    { const int h = tid & 15, d = (tid >> 4) & 15, dir = tid >> 8;
      float ak[16];
#pragma unroll
      for (int j = 0; j < 16; ++j) ak[j] = 0.f;
      for (int p = 0; p < 64; ++p) {
          const f32x2 cc = *(const f32x2*)(Cc + ((dir * 64 + p) * 16 + h) * 2), zz = *(const f32x2*)(lbp + ((dir * 17 + d) * 64 + p) * 2);
          const float czr = cc.x * zz.x - cc.y * zz.y, czi = cc.x * zz.y + cc.y * zz.x;
          const f32x4* bp = (const f32x4*)(Bb + (dir * 64 + p) * 32);
#pragma unroll
          for (int j4 = 0; j4 < 8; ++j4) { const f32x4 bq = bp[j4]; ak[2 * j4] += czr * bq[0] - czi * bq[1]; ak[2 * j4 + 1] += czr * bq[2] - czi * bq[3]; }
      }
#pragma unroll
      for (int j = 0; j < 16; ++j) Kt[((dir * 16 + d) * 16 + h) * 16 + j] = ak[j]; }
    __syncthreads();
    bf16_t* W1 = (bf16_t*)(P.ws + WS_S5W1) + (size_t)g * 256 * 256;
    for (int v = tid; v < 256 * 32; v += 512) {
        const int n = v >> 5, k0 = (v & 31) * 8, dir = n >> 7, p = (n >> 1) & 63, ri = n & 1, s = k0 >> 4, h0 = k0 & 15;
        const int d = dir ? s : 15 - s;
        const float zr = lbp[((dir * 17 + d) * 64 + p) * 2], zi = lbp[((dir * 17 + d) * 64 + p) * 2 + 1];
        float o[8];
#pragma unroll
        for (int j = 0; j < 8; ++j) { const float br = Bb[((dir * 64 + p) * 16 + h0 + j) * 2], bi = Bb[((dir * 64 + p) * 16 + h0 + j) * 2 + 1];
            o[j] = ri ? (zr * bi + zi * br) : (zr * br - zi * bi); }
        u32x4 w; w.x = cvt_pk_bf16(o[0], o[1]); w.y = cvt_pk_bf16(o[2], o[3]); w.z = cvt_pk_bf16(o[4], o[5]); w.w = cvt_pk_bf16(o[6], o[7]);
        *(u32x4*)(W1 + (size_t)n * 256 + k0) = w;
    }
    bf16_t* M2 = (bf16_t*)(P.ws + WS_S5M2) + (size_t)g * 256 * 512;
    for (int v = tid; v < 256 * 64; v += 512) {
        const int n = v & 255, k0 = (v >> 8) * 8, t = n >> 4, h = n & 15;
        float o[8];
        if (k0 < 256) { const int s = k0 >> 4, h0 = k0 & 15;
#pragma unroll
            for (int j = 0; j < 8; ++j) { float a = 0.f;
                if (s <= t) a += Kt[((0 * 16 + (t - s)) * 16 + h) * 16 + h0 + j];
                if (s >= t) a += Kt[((1 * 16 + (s - t)) * 16 + h) * 16 + h0 + j];
                o[j] = a; }
        } else { const int dir = (k0 - 256) >> 7, kk = (k0 - 256) & 127, d = dir ? 16 - t : t + 1;
#pragma unroll
            for (int j = 0; j < 8; ++j) { const int p = (kk + j) >> 1, ri = (kk + j) & 1;
                const float cr = Cc[((dir * 64 + p) * 16 + h) * 2], ci = Cc[((dir * 64 + p) * 16 + h) * 2 + 1];
                const float zr = lbp[((dir * 17 + d) * 64 + p) * 2], zi = lbp[((dir * 17 + d) * 64 + p) * 2 + 1];
                o[j] = ri ? -(cr * zi + ci * zr) : (cr * zr - ci * zi); }
        }
        u32x4 w; w.x = cvt_pk_bf16(o[0], o[1]); w.y = cvt_pk_bf16(o[2], o[3]); w.z = cvt_pk_bf16(o[4], o[5]); w.w = cvt_pk_bf16(o[6], o[7]);
        *(u32x4*)(M2 + (size_t)n * 512 + k0) = w;
    }
    __syncthreads();
}

__device__ __forceinline__ void norm_rows2(const Params& P, int rowa, int rowb, int lane) {
    const float* mod = (const float*)(P.ws + WS_MOD);
    bf16_t* nb = (bf16_t*)(P.ws + WS_A);
    const int rows[2] = {rowa, rowb};
    f32x4 v[2][4];
#pragma unroll
    for (int q = 0; q < 2; ++q) { const int row = rows[q];
        const float* src = row < MLAT ? P.x + (size_t)row * 1024 : P.ctx + (size_t)(row - MLAT) * 1024;
#pragma unroll
        for (int i = 0; i < 4; ++i) v[q][i] = __builtin_nontemporal_load((const f32x4*)(src + 4 * lane + 256 * i)); }
#pragma unroll
    for (int q = 0; q < 2; ++q) { const int row = rows[q];
        const int mr = row < MLAT ? (row >> 12) : 8;
        const float* sh = mod + mr * 6144; const float* sc = sh + 1024;
        float ss = 0.f;
#pragma unroll
        for (int i = 0; i < 4; ++i) ss += v[q][i][0] * v[q][i][0] + v[q][i][1] * v[q][i][1] + v[q][i][2] * v[q][i][2] + v[q][i][3] * v[q][i][3];
#pragma unroll
        for (int o = 32; o >= 1; o >>= 1) ss += __shfl_xor(ss, o);
        const float rstd = 1.0f / sqrtf(ss * (1.0f / 1024.0f) + NORM_EPS);
#pragma unroll
        for (int i = 0; i < 4; ++i) { const int c = 4 * lane + 256 * i;
            const f32x4 gv = *(const f32x4*)(P.attn_g + c), sv = *(const f32x4*)(sc + c), hv = *(const f32x4*)(sh + c);
            const f32x4 o = v[q][i] * rstd * gv * (sv + 1.0f) + hv;
            u32x2 w; w.x = cvt_pk_bf16(o[0], o[1]); w.y = cvt_pk_bf16(o[2], o[3]);
            *(u32x2*)(nb + (size_t)row * 1024 + c) = w; } }
}

struct TrDesc { const float* src; bf16_t* dst; int N, K, half, nstrip_k, nitems; };

__device__ void phase0(const Params& P, unsigned char* lds) {
    const int tid = threadIdx.x;
    float* Lf = (float*)lds;
    int* qslot = (int*)(lds + 100 * 1024);
    unsigned* queue = (unsigned*)(P.ws + WS_BAR) + 64;
    TrDesc td[7] = {
        {P.w_in, (bf16_t*)(P.ws + WS_WIN), INC, DM, 0, DM / 256, (INC / 64) * (DM / 256)},
        {P.w_glu, (bf16_t*)(P.ws + WS_WGLU), 2 * SW, SW, SW, SW / 256, ((2 * SW) / 64) * (SW / 256)},
        {P.w_ba, (bf16_t*)(P.ws + WS_WBA), DM, AW, 0, AW / 256, (DM / 64) * (AW / 256)},
        {P.w_bs, (bf16_t*)(P.ws + WS_WBS), DM, SW, 0, SW / 256, (DM / 64) * (SW / 256)},
        {P.w_out, (bf16_t*)(P.ws + WS_WOUT), DM, DM, 0, DM / 256, (DM / 64) * (DM / 256)},
        {P.w_fi, (bf16_t*)(P.ws + WS_WFI), 2 * FH, DM, FH, DM / 256, ((2 * FH) / 64) * (DM / 256)},
        {P.w_fo, (bf16_t*)(P.ws + WS_WFO), DM, FH, 0, FH / 256, (DM / 64) * (FH / 256)}};
    int ntr = 0;
#pragma unroll
    for (int i = 0; i < 7; ++i) ntr += td[i].nitems;
    const int NI = 32 + 96 + 1 + ntr + 128;
    unsigned* modcnt = (unsigned*)(P.ws + WS_BAR) + 128;
    for (;;) {
        __syncthreads();
        if (tid == 0) *qslot = (int)atomicAdd(queue, 1u);
        __syncthreads();
        const int it = *qslot;
        if (it >= NI) break;
        if (it >= 32 && it < 64) {
            s5_build(P, it - 32, Lf);
        } else if (it < 128) {
            const int mt = it < 32 ? it : it - 32;
            for (int idx = tid; idx < 9 * 1024; idx += 512) { const float v = idx < 8192 ? P.c[idx] : P.c_ctx[idx - 8192]; Lf[idx] = v * fast_sigmoid(v); }
            __syncthreads();
            float res[2]; int ridx[2];
            gemv_tile<9>(P.w_mod, 6 * DM, mt * 64, Lf, Lf + 9 * 1024, res, ridx);
#pragma unroll
            for (int e = 0; e < 2; ++e) if (ridx[e] < 9 * 64) { const int r = ridx[e] >> 6, cc = ridx[e] & 63; ((float*)(P.ws + WS_MOD))[r * 6144 + mt * 64 + cc] = res[e] + P.b_mod[mt * 64 + cc]; }
            if (mt < 32) {
                asm volatile("s_waitcnt vmcnt(0)" ::: "memory"); __syncthreads();
                if (tid == 0) { __builtin_amdgcn_fence(__ATOMIC_RELEASE, "agent"); asm volatile("s_waitcnt vmcnt(0)" ::: "memory");
                    __hip_atomic_fetch_add(modcnt, 1u, __ATOMIC_RELAXED, __HIP_MEMORY_SCOPE_AGENT); }
            }
        } else if (it == 128) {
            for (int idx = tid; idx < 1024; idx += 512) { const int pos = idx >> 4, i = idx & 15;
                const float invf = expf(-(float)i * (1.0f / 16.0f) * 9.210340371976184f);
                float sn, cs; sincos_d((double)((float)pos * invf), sn, cs);
                ((f32x2*)(P.ws + WS_ROPE))[idx] = (f32x2){cs, sn}; }
        } else if (it >= 129 + ntr) {
            if (tid == 0) { unsigned spins = 0;
                while (__hip_atomic_load(modcnt, __ATOMIC_RELAXED, __HIP_MEMORY_SCOPE_AGENT) < 32u) { __builtin_amdgcn_s_sleep(4); if (++spins > (1u << 22)) break; }
                __builtin_amdgcn_fence(__ATOMIC_ACQUIRE, "agent"); asm volatile("s_waitcnt vmcnt(0)" ::: "memory"); }
            __syncthreads();
            const int base = MLAT + (it - 129 - ntr) * 16, wave = tid >> 6;
            norm_rows2(P, base + wave, base + 8 + wave, tid & 63);
        } else {
            int j = it - 129, w = 0;
#pragma unroll
            for (int i = 0; i < 6; ++i) if (w == i && j >= td[i].nitems) { j -= td[i].nitems; w = i + 1; }
            const float* src = td[0].src; bf16_t* dst = td[0].dst; int N = td[0].N, K = td[0].K, half = td[0].half, nk = td[0].nstrip_k;
#pragma unroll
            for (int i = 1; i < 7; ++i) if (w == i) { src = td[i].src; dst = td[i].dst; N = td[i].N; K = td[i].K; half = td[i].half; nk = td[i].nstrip_k; }
            tr_strip(src, N, K, j % nk, j / nk, dst, half, (unsigned short*)lds);
        }
    }
}

__device__ void phase1(const Params& P, unsigned char* lds) {
    const int tid = threadIdx.x, G = gridDim.x, lane = tid & 63, wave = tid >> 6;
    float* Lf = (float*)lds;
    const float* mod = (const float*)(P.ws + WS_MOD);
    for (int it = blockIdx.x; it < 88; it += G) {
        for (int idx = tid; idx < 8 * 1024; idx += 512) Lf[idx] = mod[(idx >> 10) * 6144 + 3 * 1024 + (idx & 1023)];
        __syncthreads();
        float res[2]; int ridx[2];
        gemv_tile<8>(P.w_fi, 2 * FH, it * 64, Lf, Lf + 8 * 1024, res, ridx);
        if (ridx[0] < 8 * 64) { const int r = ridx[0] >> 6, ncol = it * 64 + (ridx[0] & 63);
            const int drow = ncol < FH ? ((ncol >> 7) * 256 + (ncol & 127)) : (((ncol - FH) >> 7) * 256 + 128 + ((ncol - FH) & 127));
            ((float*)(P.ws + WS_BIAS2))[r * 5632 + drow] = res[0]; }
    }
    const int NBR = G > 96 ? G - 48 : G;
    for (int row0 = blockIdx.x * 8 + wave; row0 < MLAT; row0 += NBR * 16) {
        const int rb = row0 + NBR * 8;
        norm_rows2(P, row0, rb < MLAT ? rb : row0, lane);
    }
}

__device__ __forceinline__ void scan_task(const Params& P, int task, int lane) {
    const int g = task >> 4, dir = (task >> 3) & 1, b = task & 7, p = lane;
    const f32x2 lb = ((const f32x2*)(P.ws + WS_LBT))[(dir * 32 + g) * 64 + p];
    const float* __restrict__ Eg = (const float*)(P.ws + WS_E) + (size_t)g * XH_ROWS * 256 + dir * 128 + 2 * p;
    unsigned* __restrict__ xh = (unsigned*)((bf16_t*)(P.ws + WS_D) + (size_t)g * XH_ROWS * 512 + 256 + dir * 128 + 2 * p);
    float hr = 0.f, hi = 0.f;
    f32x2 e[16];
#pragma unroll
    for (int i = 0; i < 16; ++i) { const int cc = dir ? 15 - i : i; e[i] = *(const f32x2*)(Eg + (size_t)(2048 + b * 16 + cc) * 256); }
#pragma unroll
    for (int i = 0; i < 16; ++i) { const float nr = lb.x * hr - lb.y * hi + e[i].x, ni = lb.x * hi + lb.y * hr + e[i].y; hr = nr; hi = ni; }
    f32x2 en[32];
#pragma unroll
    for (int i = 0; i < 32; ++i) { const int c = dir ? 255 - i : i; en[i] = *(const f32x2*)(Eg + (size_t)(b * 256 + c) * 256); }
#pragma unroll 1
    for (int blk = 0; blk < 8; ++blk) {
        f32x2 ec[32];
#pragma unroll
        for (int i = 0; i < 32; ++i) ec[i] = en[i];
        if (blk < 7) {
#pragma unroll
            for (int i = 0; i < 32; ++i) { const int ci = (blk + 1) * 32 + i; const int c = dir ? 255 - ci : ci; en[i] = *(const f32x2*)(Eg + (size_t)(b * 256 + c) * 256); }
        }
#pragma unroll
        for (int i = 0; i < 32; ++i) { const int ci = blk * 32 + i; const int c = dir ? 255 - ci : ci;
            xh[(size_t)(b * 256 + c) * 256] = cvt_pk_bf16(hr, hi);
            const float nr = lb.x * hr - lb.y * hi + ec[i].x, ni = lb.x * hi + lb.y * hr + ec[i].y; hr = nr; hi = ni; }
    }
}

constexpr int ATT_LK = 0, ATT_LV = 256 * 144, ATT_LB = ATT_LV + 32768, ATT_LC = ATT_LB + 2048;

template <bool LOC, int NT>
__device__ __forceinline__ void att_sm_pv(f32x4 (&s)[NT], const bf16x8 (&vv)[NT / 2][4], f32x4 (&o)[5], float& mrun,
                                          const float* rpbl, const int (&dcl)[8], unsigned inw, int dr) {
    const float SC = 0.125f * LOG2E;
    float mnew;
    if (LOC) {
        float mx = -1e30f;
#pragma unroll
        for (int tile = 0; tile < NT; ++tile)
#pragma unroll
            for (int j = 0; j < 4; ++j) { const int jj = 4 * (tile & 1) + j;
                const float bv = rpbl[dr * 31 + dcl[jj]];
                const float tv = __builtin_fmaf(s[tile][j], SC, bv);
                const float v = ((inw >> jj) & 1u) ? tv : -1e30f;
                s[tile][j] = v; mx = fmaxf(mx, v); }
        mx = xmax16(xmax32(mx));
        mnew = fmaxf(mrun, mx);
#pragma unroll
        for (int tile = 0; tile < NT; ++tile)
#pragma unroll
            for (int j = 0; j < 4; ++j) s[tile][j] = __builtin_amdgcn_exp2f(s[tile][j] - mnew);
    } else {
        float mx = -1e30f;
#pragma unroll
        for (int tile = 0; tile < NT; ++tile)
#pragma unroll
            for (int j = 0; j < 4; ++j) mx = fmaxf(mx, s[tile][j]);
        mx = xmax16(xmax32(mx)) * SC;
        mnew = fmaxf(mrun, mx);
#pragma unroll
        for (int tile = 0; tile < NT; ++tile)
#pragma unroll
            for (int j = 0; j < 4; ++j) s[tile][j] = __builtin_amdgcn_exp2f(__builtin_fmaf(s[tile][j], SC, -mnew));
    }
    if (__builtin_amdgcn_ballot_w64(mnew > mrun) != 0ull) {
        const float alpha = __builtin_amdgcn_exp2f(mrun - mnew);
#pragma unroll
        for (int d = 0; d < 5; ++d) o[d] *= alpha;
    }
    mrun = mnew;
    const bf16x8 ones = {(short)0x3F80, (short)0x3F80, (short)0x3F80, (short)0x3F80, (short)0x3F80, (short)0x3F80, (short)0x3F80, (short)0x3F80};
#pragma unroll
    for (int kb2 = 0; kb2 < NT / 2; ++kb2) {
        u32x4 pw; pw.x = cvt_pk_bf16(s[2 * kb2][0], s[2 * kb2][1]); pw.y = cvt_pk_bf16(s[2 * kb2][2], s[2 * kb2][3]);
        pw.z = cvt_pk_bf16(s[2 * kb2 + 1][0], s[2 * kb2 + 1][1]); pw.w = cvt_pk_bf16(s[2 * kb2 + 1][2], s[2 * kb2 + 1][3]);
        bf16x8 pb; __builtin_memcpy(&pb, &pw, 16);
#pragma unroll
        for (int d = 0; d < 4; ++d) o[d] = __builtin_amdgcn_mfma_f32_16x16x32_bf16(vv[kb2][d], pb, o[d], 0, 0, 0);
        o[4] = __builtin_amdgcn_mfma_f32_16x16x32_bf16(ones, pb, o[4], 0, 0, 0);
    }
}

__device__ __forceinline__ void attn_task2(const Params& P, int b, int h, int rA, int cb, int lane, const float* rpbl, const LAS unsigned char* ldsl) {
    const int n = lane & 15, g4 = lane >> 4;
    const bf16_t* qb = (const bf16_t*)(P.ws + WS_B);
    const bf16_t* kb = (const bf16_t*)(P.ws + WS_C);
    const bf16_t* vt = kb + (size_t)MALL * 512;
    bf16_t* ab = (bf16_t*)(P.ws + WS_A);
    const int tqA = rA * 64 + cb * 16 + n;
    const bf16_t* qp = qb + ((size_t)(b * 4096 + tqA)) * 512 + h * 64 + 8 * g4;
    const bf16x8 qA0 = *(const bf16x8*)qp, qA1 = *(const bf16x8*)(qp + 32), qB0 = *(const bf16x8*)(qp + 64 * 512), qB1 = *(const bf16x8*)(qp + 64 * 512 + 32);
    const int rsA = min(max(rA - 4, 0), 56), rsB = min(max(rA - 3, 0), 56), bs = min(max(16 * cb - 8, 0), 32);
    const int qcol = 16 * cb + n, cst = min(max(qcol - 8, 0), 48);
    int dcl[8]; unsigned inw = 0;
#pragma unroll
    for (int jj = 0; jj < 8; ++jj) { const int kcol = bs + 8 * g4 + jj; if (kcol >= cst && kcol < cst + 16) inw |= 1u << jj; dcl[jj] = min(max(kcol - qcol, -15), 15) + 15; }
    f32x4 oA[5], oB[5];
#pragma unroll
    for (int d = 0; d < 5; ++d) { oA[d] = (f32x4){0.f, 0.f, 0.f, 0.f}; oB[d] = (f32x4){0.f, 0.f, 0.f, 0.f}; }
    float mA = -1e30f, mB = -1e30f;
    const int kx = 8 * (n >> 2) + (n & 3);
    const bf16_t* kloc = kb + ((size_t)b * 4096 + bs + kx) * 512 + h * 64 + 8 * g4;
    const bf16_t* vloc = vt + ((size_t)(b * 8 + h) * 512 + bs / 8 + g4) * 512 + n * 8;
    bf16x8 kc[2][2], kn[2][2], vc[1][4], vn[1][4];
#define ATT_LOADROW(kd, vd, row) do { _Pragma("unroll") for (int tile = 0; tile < 2; ++tile) { \
        const bf16_t* kp_ = kloc + (size_t)(row) * (64 * 512) + tile * (4 * 512); kd[tile][0] = *(const bf16x8*)kp_; kd[tile][1] = *(const bf16x8*)(kp_ + 32); } \
        _Pragma("unroll") for (int d = 0; d < 4; ++d) vd[0][d] = *(const bf16x8*)(vloc + (size_t)(row) * (8 * 512) + d * 128); } while (0)
    ATT_LOADROW(kc, vc, rsA);
    const LAS unsigned char* lk = ldsl + ATT_LK + kx * 144 + g4 * 16;
    const LAS unsigned char* lv = ldsl + ATT_LV + (g4 * 64 + n) * 16;
#pragma unroll 1
    for (int step = 0; step < 4; ++step) {
        f32x4 sA[4], sB[4]; bf16x8 vl[2][4];
#pragma unroll
        for (int tile = 0; tile < 4; ++tile) {
            const LAS unsigned char* kp = lk + (2 * step + (tile >> 1)) * (32 * 144) + (tile & 1) * (4 * 144);
            const bf16x8 k0 = *(const LAS bf16x8*)kp, k1 = *(const LAS bf16x8*)(kp + 64);
            sA[tile] = __builtin_amdgcn_mfma_f32_16x16x32_bf16(k0, qA0, (f32x4){0.f, 0.f, 0.f, 0.f}, 0, 0, 0);
            sA[tile] = __builtin_amdgcn_mfma_f32_16x16x32_bf16(k1, qA1, sA[tile], 0, 0, 0);
            sB[tile] = __builtin_amdgcn_mfma_f32_16x16x32_bf16(k0, qB0, (f32x4){0.f, 0.f, 0.f, 0.f}, 0, 0, 0);
            sB[tile] = __builtin_amdgcn_mfma_f32_16x16x32_bf16(k1, qB1, sB[tile], 0, 0, 0);
        }
#pragma unroll
        for (int kb2 = 0; kb2 < 2; ++kb2)
#pragma unroll
            for (int d = 0; d < 4; ++d) vl[kb2][d] = *(const LAS bf16x8*)(lv + (2 * step + kb2) * 4096 + d * 256);
        att_sm_pv<false, 4>(sA, vl, oA, mA, rpbl, dcl, inw, 0);
        att_sm_pv<false, 4>(sB, vl, oB, mB, rpbl, dcl, inw, 0);
    }
    const int klast = rsB + 7;
#pragma unroll 1
    for (int k = rsA; k <= klast; ++k) {
        if (k < klast) ATT_LOADROW(kn, vn, k + 1);
        const bool useA = k < rsA + 8, useB = k >= rsB;
        if (useA && useB) {
            f32x4 sa[2], sb[2];
#pragma unroll
            for (int tile = 0; tile < 2; ++tile) {
                sa[tile] = __builtin_amdgcn_mfma_f32_16x16x32_bf16(kc[tile][0], qA0, (f32x4){0.f, 0.f, 0.f, 0.f}, 0, 0, 0);
                sb[tile] = __builtin_amdgcn_mfma_f32_16x16x32_bf16(kc[tile][0], qB0, (f32x4){0.f, 0.f, 0.f, 0.f}, 0, 0, 0);
                sa[tile] = __builtin_amdgcn_mfma_f32_16x16x32_bf16(kc[tile][1], qA1, sa[tile], 0, 0, 0);
                sb[tile] = __builtin_amdgcn_mfma_f32_16x16x32_bf16(kc[tile][1], qB1, sb[tile], 0, 0, 0); }
            att_sm_pv<true, 2>(sa, vc, oA, mA, rpbl, dcl, inw, k - rA + 7);
            att_sm_pv<true, 2>(sb, vc, oB, mB, rpbl, dcl, inw, k - (rA + 1) + 7);
        } else if (useA) {
            f32x4 s[2];
#pragma unroll
            for (int tile = 0; tile < 2; ++tile) {
                s[tile] = __builtin_amdgcn_mfma_f32_16x16x32_bf16(kc[tile][0], qA0, (f32x4){0.f, 0.f, 0.f, 0.f}, 0, 0, 0);
                s[tile] = __builtin_amdgcn_mfma_f32_16x16x32_bf16(kc[tile][1], qA1, s[tile], 0, 0, 0); }
            att_sm_pv<true, 2>(s, vc, oA, mA, rpbl, dcl, inw, k - rA + 7);
        } else {
            f32x4 s[2];
#pragma unroll
            for (int tile = 0; tile < 2; ++tile) {
                s[tile] = __builtin_amdgcn_mfma_f32_16x16x32_bf16(kc[tile][0], qB0, (f32x4){0.f, 0.f, 0.f, 0.f}, 0, 0, 0);
                s[tile] = __builtin_amdgcn_mfma_f32_16x16x32_bf16(kc[tile][1], qB1, s[tile], 0, 0, 0); }
            att_sm_pv<true, 2>(s, vc, oB, mB, rpbl, dcl, inw, k - (rA + 1) + 7);
        }
#pragma unroll
        for (int tile = 0; tile < 2; ++tile) { kc[tile][0] = kn[tile][0]; kc[tile][1] = kn[tile][1]; }
#pragma unroll
        for (int d = 0; d < 4; ++d) vc[0][d] = vn[0][d];
    }
#undef ATT_LOADROW
    const float invA = 1.0f / oA[4][0], invB = 1.0f / oB[4][0];
    bf16_t* op = ab + ((size_t)(b * 4096 + tqA)) * 512 + h * 64 + 4 * g4;
#pragma unroll
    for (int d = 0; d < 4; ++d) {
        u32x2 w; w.x = cvt_pk_bf16(oA[d][0] * invA, oA[d][1] * invA); w.y = cvt_pk_bf16(oA[d][2] * invA, oA[d][3] * invA); *(u32x2*)(op + 16 * d) = w;
        u32x2 w2; w2.x = cvt_pk_bf16(oB[d][0] * invB, oB[d][1] * invB); w2.y = cvt_pk_bf16(oB[d][2] * invB, oB[d][3] * invB); *(u32x2*)(op + 64 * 512 + 16 * d) = w2; }
}

__device__ void phase4(const Params& P, unsigned char* lds) {
    const int tid = threadIdx.x, G = gridDim.x, lane = tid & 63, wave = tid >> 6;
    const LAS unsigned char* ldsl = (const LAS unsigned char*)lds;
    float* rpbl = (float*)(lds + ATT_LB);
    int* ctr = (int*)(lds + ATT_LC);
    if (wave < 2) for (int task = blockIdx.x * 2 + wave; task < 512; task += G * 2) scan_task(P, task, lane);
    const bf16_t* kb = (const bf16_t*)(P.ws + WS_C);
    const bf16_t* vtc = kb + (size_t)MALL * 512 + (size_t)MLAT * 512;
    for (int bt = blockIdx.x; bt < 256; bt += G) {
        const int xcd = bt & 7, j = bt >> 3, pair = xcd * 8 + (j >> 2), quarter = j & 3, b = pair >> 3, h = pair & 7;
        __syncthreads();
        for (int idx = tid; idx < 15 * 31; idx += 512) rpbl[idx] = P.rpb[h * 465 + idx] * LOG2E;
        if (tid == 0) *ctr = 0;
#pragma unroll 1
        for (int i = 0; i < 4; ++i) { const int e = tid + 512 * i, key = e >> 3, ch = e & 7;
            const u32x4 kvv = *(const u32x4*)(kb + ((size_t)MLAT + b * 256 + key) * 512 + h * 64 + ch * 8);
            *(u32x4*)(lds + ATT_LK + key * 144 + ch * 16) = kvv;
            const u32x4 vvv = *(const u32x4*)(vtc + (size_t)(b * 8 + h) * 32 * 512 + (size_t)e * 8);
            *(u32x4*)(lds + ATT_LV + e * 16) = vvv; }
        __syncthreads();
        for (;;) {
            int t = 0; if (lane == 0) t = atomicAdd(ctr, 1);
            t = __shfl(t, 0);
            if (t >= 32) break;
            attn_task2(P, b, h, quarter * 16 + 2 * (t >> 2), t & 3, lane, rpbl, ldsl);
        }
    }
}

__device__ void phase_final(const Params& P) {
    const int tid = threadIdx.x, G = gridDim.x, lane = tid & 63, wave = tid >> 6;
    const float* ss = (const float*)(P.ws + WS_SSP2);
    const bf16_t* hb = (const bf16_t*)(P.ws + WS_F);
    for (int row0 = blockIdx.x * 8 + wave; row0 < MLAT; row0 += G * 16) {
        const int rows[2] = {row0, row0 + G * 8};
        u32x2 hq[2][4]; f32x4 sp[2];
#pragma unroll
        for (int q = 0; q < 2; ++q) { const int row = rows[q] < MLAT ? rows[q] : row0;
            sp[q] = *(const f32x4*)(ss + (size_t)row * 16 + 4 * (lane & 3));
#pragma unroll
            for (int i = 0; i < 4; ++i) hq[q][i] = __builtin_nontemporal_load((const u32x2*)(hb + (size_t)row * 1024 + 4 * lane + 256 * i)); }
#pragma unroll
        for (int q = 0; q < 2; ++q) { const int row = rows[q]; if (row >= MLAT) continue;
            float t = (sp[q][0] + sp[q][1]) + (sp[q][2] + sp[q][3]); t += __shfl_xor(t, 1); t += __shfl_xor(t, 2);
            const float rstd = 1.0f / sqrtf(t * (1.0f / 1024.0f) + NORM_EPS);
#pragma unroll
            for (int i = 0; i < 4; ++i) { const int c = 4 * lane + 256 * i;
                const f32x4 v = (f32x4){bflo(hq[q][i].x), bfhi(hq[q][i].x), bflo(hq[q][i].y), bfhi(hq[q][i].y)}, gv = *(const f32x4*)(P.final_g + c);
                __builtin_nontemporal_store(v * rstd * gv, (f32x4*)(P.out + (size_t)row * 1024 + c)); } }
    }
}

#define XB_TMO      128
#define XB_XCNT(j)  (256  + 64 * (j))
#define XB_XSUB(j)  (1280 + 64 * (j))
#define XB_XGEN(j)  (2304 + 64 * (j))
#define XB_TOP      3328
#define XB_TOPGEN   3392
#define XCD_BAR_WORDS 3456
#define XB_SPIN_CAP (1u << 18)

__device__ __forceinline__ unsigned xb_ld(unsigned* p)              { return __hip_atomic_load(p, __ATOMIC_RELAXED, __HIP_MEMORY_SCOPE_AGENT); }
__device__ __forceinline__ unsigned xb_add(unsigned* p, unsigned v) { return __hip_atomic_fetch_add(p, v, __ATOMIC_RELAXED, __HIP_MEMORY_SCOPE_AGENT); }
__device__ __forceinline__ unsigned xb_xcc_id() { return (unsigned)__builtin_amdgcn_s_getreg((3 << 11) | 20) & 0xFu; }
#define XB_SPIN(cond, bar) do { unsigned _sp = 0; while (cond) { __builtin_amdgcn_s_sleep(1); \
    if ((++_sp & 255u) == 0u) { if (xb_ld(&(bar)[XB_TMO])) break; if (_sp > XB_SPIN_CAP) { atomicAdd(&(bar)[XB_TMO], 1u); break; } } } } while (0)

struct XcdBarrier {
    unsigned* bar; unsigned x;
    volatile LAS unsigned* st;
};

__device__ __forceinline__ XcdBarrier xcd_barrier_post(unsigned* bar, volatile LAS unsigned* st) {
    XcdBarrier b; b.bar = bar; b.x = xb_xcc_id(); b.st = st;
    if (threadIdx.x == 0) (void)xb_add(&bar[XB_XCNT(b.x)], 1u);
    return b;
}
__device__ __forceinline__ void xcd_barrier_complete(unsigned* bar, unsigned x, unsigned& nloc, unsigned& nx) {
    const unsigned G = gridDim.x * gridDim.y * gridDim.z;
    unsigned sum, cnt, mine, sp = 0u;
    for (;;) {
        sum = 0u; cnt = 0u; mine = 0u;
#pragma unroll
        for (unsigned j = 0; j < 16; ++j) { const unsigned c = xb_ld(&bar[XB_XCNT(j)]); sum += c; cnt += (c > 0u) ? 1u : 0u; mine = (j == x) ? c : mine; }
        if (sum == G) break;
        __builtin_amdgcn_s_sleep(1);
        if ((++sp & 255u) == 0u) { if (xb_ld(&bar[XB_TMO])) break; if (sp > XB_SPIN_CAP) { atomicAdd(&bar[XB_TMO], 1u); break; } }
    }
    nloc = mine > 0u ? mine : 1u; nx = cnt > 0u ? cnt : 1u;
}

__device__ __forceinline__ void xcd_barrier(const XcdBarrier& b) {
    asm volatile("s_waitcnt vmcnt(0)" ::: "memory");
    __syncthreads();
    if (threadIdx.x == 0) {
        unsigned* bar = b.bar;
        __builtin_amdgcn_s_waitcnt(0);
        unsigned nloc = b.st[0], nx = b.st[1];
        if (nloc == 0u) { xcd_barrier_complete(bar, b.x, nloc, nx); b.st[0] = nloc; b.st[1] = nx; }
        const unsigned old = xb_add(&bar[XB_XSUB(b.x)], 1u);
        const unsigned gen = old / nloc;
        if (old + 1u == (gen + 1u) * nloc) {
            __builtin_amdgcn_fence(__ATOMIC_RELEASE, "agent");
            asm volatile("s_waitcnt vmcnt(0)" ::: "memory");
            const unsigned og = xb_add(&bar[XB_TOP], 1u);
            const unsigned tg = og / nx;
            if (og + 1u == (tg + 1u) * nx) xb_add(&bar[XB_TOPGEN], 1u);
            else XB_SPIN(xb_ld(&bar[XB_TOPGEN]) == tg, bar);
            __builtin_amdgcn_fence(__ATOMIC_ACQUIRE, "agent");
            xb_add(&bar[XB_XGEN(b.x)], 1u);
            asm volatile("s_waitcnt vmcnt(0)" ::: "memory");
        } else {
            XB_SPIN(xb_ld(&bar[XB_XGEN(b.x)]) == gen, bar);
            __builtin_amdgcn_fence(__ATOMIC_ACQUIRE, "agent");
            asm volatile("s_waitcnt vmcnt(0)" ::: "memory");
        }
    }
    __syncthreads();
}

constexpr int LDS_BYTES = pg8::STAGE_BYTES + 16;
constexpr int NPHASE = 12;

__global__ void __launch_bounds__(512, 2) fwd_kernel(Params P) {
    extern __shared__ __attribute__((aligned(16))) unsigned char lds[];
    LAS unsigned char* ldsl = (LAS unsigned char*)lds;
    const int G = gridDim.x, cidx = blockIdx.x;
    const int lo = P.ph_lo, hi = P.ph_hi;
#define IN(k) (lo <= (k) && (k) < hi)
    unsigned* barw = (unsigned*)(P.ws + WS_BAR);
    (void)barw;
    volatile LAS unsigned* xst = (volatile LAS unsigned*)(ldsl + pg8::STAGE_BYTES);
    if (threadIdx.x < 4) xst[threadIdx.x] = 0u;
    __syncthreads();
    const XcdBarrier xbar = xcd_barrier_post((unsigned*)(P.ws + WS_BAR + 4096), xst);
#define SEAM(k) do { if (IN(k) && IN((k) + 1)) { if ((k) == 0) cg::this_grid().sync(); else { xcd_barrier(xbar); } } } while (0)
    bf16_t* ws16 = (bf16_t*)P.ws;
    const float* mod = (const float*)(P.ws + WS_MOD);
    if (IN(0)) { phase0(P, lds); } SEAM(0);
    if (IN(1)) {
        const bool split = G > 96, gemm_wg = !split || cidx >= G - 48;
        if (!split || !gemm_wg) phase1(P, lds);
        if (gemm_wg) {
            if (!split) __syncthreads();
            pg8::Gemm g{(const bf16_t*)(P.ws + WS_A), (const bf16_t*)(P.ws + WS_WIN), DM, DM, DM};
            pg8::CtxOrder S{split ? 48 : G, split ? cidx - (G - 48) : cidx};
            bf16_t* kb = (bf16_t*)(P.ws + WS_C);
            EpiInProj E{(bf16_t*)(P.ws + WS_B), kb, kb + (size_t)MALL * 512, kb + (size_t)MALL * 512 + (size_t)MLAT * 512, (bf16_t*)(P.ws + WS_D), (bf16_t*)(P.ws + WS_F), (const f32x2*)(P.ws + WS_ROPE)};
            pg8::gemm_phase(ldsl, g, S, E);
        }
    } SEAM(1);
    if (IN(2)) {
        pg8::Gemm g{(const bf16_t*)(P.ws + WS_A), (const bf16_t*)(P.ws + WS_WIN), DM, DM, DM};
        pg8::StaticOrder S; S.init(MLAT, INC, G, cidx);
        bf16_t* kb = (bf16_t*)(P.ws + WS_C);
        EpiInProj E{(bf16_t*)(P.ws + WS_B), kb, kb + (size_t)MALL * 512, kb + (size_t)MALL * 512 + (size_t)MLAT * 512, (bf16_t*)(P.ws + WS_D), (bf16_t*)(P.ws + WS_F), (const f32x2*)(P.ws + WS_ROPE)};
        pg8::gemm_phase<EpiInProj, pg8::StaticOrder, true, true>(ldsl, g, S, E);
    } SEAM(2);
    if (IN(3)) {
        pg8::Gemm g{(const bf16_t*)(P.ws + WS_D), (const bf16_t*)(P.ws + WS_S5W1), 512, 256, 256};
        pg8::S5Order<9> S; S.init(G, cidx);
        EpiE E{(float*)(P.ws + WS_E)};
        pg8::gemm_phase(ldsl, g, S, E);
    } SEAM(3);
    if (IN(4)) { phase4(P, lds); } SEAM(4);
    if (IN(5)) {
        { pg8::Gemm g{(const bf16_t*)(P.ws + WS_D), (const bf16_t*)(P.ws + WS_S5M2), 512, 512, 512};
          pg8::S5Order<8> S; S.init(G, cidx);
          EpiY E{(const bf16_t*)(P.ws + WS_D), P.ssm_d, (bf16_t*)(P.ws + WS_A) + (size_t)MLAT * 512};
          pg8::gemm_phase(ldsl, g, S, E); }
        { pg8::Gemm g{(const bf16_t*)(P.ws + WS_A), (const bf16_t*)(P.ws + WS_WBA), AW, AW, AW};
          pg8::StaticOrder S; S.init(MLAT, DM, G, cidx);
          EpiBranch<0> E{(const bf16_t*)(P.ws + WS_F), (bf16_t*)(P.ws + WS_C)};
          pg8::gemm_phase<EpiBranch<0>, pg8::StaticOrder, true, true>(ldsl, g, S, E); }
    } SEAM(5);
    if (IN(6)) {
        pg8::Gemm g{(const bf16_t*)(P.ws + WS_A) + (size_t)MLAT * 512, (const bf16_t*)(P.ws + WS_WGLU), SW, SW, SW};
        pg8::StaticOrder S; S.init(MLAT, 2 * SW, G, cidx);
        EpiGLU E{(bf16_t*)(P.ws + WS_B), SW};
        pg8::gemm_phase<EpiGLU, pg8::StaticOrder, true, true>(ldsl, g, S, E);
    } SEAM(6);
    if (IN(7)) {
        pg8::Gemm g{(const bf16_t*)(P.ws + WS_B), (const bf16_t*)(P.ws + WS_WBS), SW, SW, SW};
        pg8::StaticOrder S; S.init(MLAT, DM, G, cidx);
        EpiBranch<1> E{(const bf16_t*)(P.ws + WS_F) + 1024, (bf16_t*)(P.ws + WS_C)};
        pg8::gemm_phase<EpiBranch<1>, pg8::StaticOrder, true, true>(ldsl, g, S, E);
    } SEAM(7);
    if (IN(8)) {
        pg8::Gemm g{(const bf16_t*)(P.ws + WS_C), (const bf16_t*)(P.ws + WS_WOUT), DM, DM, DM};
        pg8::StaticOrder S; S.init(MLAT, DM, G, cidx);
        EpiWout E{P.x, mod, P.ffn_g, (bf16_t*)(P.ws + WS_F), (bf16_t*)(P.ws + WS_E), (float*)(P.ws + WS_SSP1)};
        pg8::gemm_phase<EpiWout, pg8::StaticOrder, true, true>(ldsl, g, S, E);
    } SEAM(8);
    if (IN(9)) {
        pg8::Gemm g{(const bf16_t*)(P.ws + WS_E), (const bf16_t*)(P.ws + WS_WFI), DM, DM, DM};
        pg8::StaticOrder S; S.init(MLAT, 2 * FH, G, cidx);
        EpiFFNIn E{(const float*)(P.ws + WS_SSP1), (const float*)(P.ws + WS_BIAS2), (bf16_t*)(P.ws + WS_HID)};
        pg8::gemm_phase<EpiFFNIn, pg8::StaticOrder, true, true>(ldsl, g, S, E);
    } SEAM(9);
    if (IN(10)) {
        pg8::Gemm g{(const bf16_t*)(P.ws + WS_HID), (const bf16_t*)(P.ws + WS_WFO), FH, FH, FH};
        pg8::StaticOrder S; S.init(MLAT, DM, G, cidx);
        EpiFFNOut E{mod, (bf16_t*)(P.ws + WS_F), (float*)(P.ws + WS_SSP2)};
        pg8::gemm_phase<EpiFFNOut, pg8::StaticOrder, true, true>(ldsl, g, S, E);
    } SEAM(10);
    if (IN(11)) { phase_final(P); }
    (void)ws16;
#undef IN
#undef SEAM
}

extern "C" void kernel_launch(void* const* d_in, const int* in_sizes, int n_in, void* d_out, int out_size, void* d_ws, size_t ws_size, hipStream_t stream) {
    static int grid = 0;
    if (grid == 0) {
        int dev = 0, cus = 0, per_cu = 0;
        (void)hipGetDevice(&dev);
        (void)hipDeviceGetAttribute(&cus, hipDeviceAttributeMultiprocessorCount, dev);
        (void)hipFuncSetAttribute((const void*)fwd_kernel, hipFuncAttributeMaxDynamicSharedMemorySize, LDS_BYTES);
        (void)hipOccupancyMaxActiveBlocksPerMultiprocessor(&per_cu, (const void*)fwd_kernel, 512, LDS_BYTES);
        if (per_cu < 1) { fprintf(stderr, "kernel_launch: occupancy query says %d blocks per CU\n", per_cu); per_cu = 1; }
        grid = cus;
        if (ws_size < WS_END) fprintf(stderr, "kernel_launch: workspace too small: %zu < %zu\n", ws_size, (size_t)WS_END);
    }
    Params p{};
    const float** pp = (const float**)&p;
    for (int i = 0; i < 25; ++i) pp[i] = (const float*)d_in[i];
    p.out = (float*)d_out; p.ws = (unsigned char*)d_ws;
#if ONE_LAUNCH
    (void)hipMemsetAsync((unsigned char*)d_ws + WS_BAR, 0, 4096 + XCD_BAR_WORDS * 4, stream);
    p.ph_lo = 0; p.ph_hi = NPHASE;
    void* args[] = {&p};
    hipError_t e = hipLaunchCooperativeKernel((const void*)fwd_kernel, dim3(grid), dim3(512), args, LDS_BYTES, stream);
    if (e != hipSuccess) fprintf(stderr, "cooperative launch failed: %s (grid %d)\n", hipGetErrorString(e), grid);
#else
    for (int ph = 0; ph < NPHASE; ++ph) {
        p.ph_lo = ph; p.ph_hi = ph + 1;
        hipLaunchKernelGGL(fwd_kernel, dim3(grid), dim3(512), LDS_BYTES, stream, p);
    }
#endif
}
```
